# Optimizing an MI355X kernel written in HIP

```python
import math
import jax
import jax.numpy as jnp
from jax import lax
import numpy as np

D_MODEL = 1024
BATCH = 2
SEQ = 16384
DEPTH = 2

CHUNK = 64
CONV_WIDTH = 4
EPS = 1e-6

RET_HEADS = 4
RET_DK = 128
RET_DV = 128
RET_QK_W = RET_HEADS * RET_DK
RET_V_W = RET_HEADS * RET_DV
ROPE_THETA = 10000.0

SSD_HEADS = 8
SSD_HEAD_DIM = 64
SSD_GROUPS = 2
SSD_STATE = 128
SSD_INNER = SSD_HEADS * SSD_HEAD_DIM
SSD_XBC_W = SSD_INNER + 2 * SSD_GROUPS * SSD_STATE

GDN_HEADS = 6
GDN_DK = 128
GDN_DV = 128
GDN_QK_W = GDN_HEADS * GDN_DK
GDN_V_W = GDN_HEADS * GDN_DV
GDN_QKV_W = 2 * GDN_QK_W + GDN_V_W

S5_CH = 256
S5_GROUP = 16
S5_GROUPS = S5_CH // S5_GROUP
S5_STATE = 64

D_FF = 4 * D_MODEL

MIX0_W = RET_V_W + SSD_INNER
MIX1_W = GDN_V_W + S5_CH
IN0_W = 2 * RET_QK_W + 2 * RET_V_W + SSD_INNER + SSD_XBC_W + SSD_HEADS
IN1_W = GDN_QKV_W + GDN_V_W + 2 * GDN_HEADS + S5_CH

kernel_name = "hybrid_retention_ssd_gdn_s5_trunk"


def rmsnorm(x, w):
    xf = x.astype(jnp.float32)
    y = xf * lax.rsqrt(jnp.mean(xf * xf, axis=-1, keepdims=True) + EPS)
    return (y * w.astype(jnp.float32)).astype(x.dtype)


def unit_rms(x):
    return x * lax.rsqrt(jnp.mean(x * x, axis=-1, keepdims=True) + EPS)


def l2norm(x):
    return x * lax.rsqrt(jnp.sum(x * x, axis=-1, keepdims=True) + EPS)


def causal_dwconv(x, w):
    k = w.shape[0]
    return lax.conv_general_dilated(
        x, w[:, None, :].astype(x.dtype), window_strides=(1,), padding=[(k - 1, 0)],
        dimension_numbers=("NWC", "WIO", "NWC"), feature_group_count=x.shape[-1])


def rotary(x, pos):
    half = x.shape[-1] // 2
    inv = ROPE_THETA ** (-jnp.arange(half, dtype=jnp.float32) / half)
    ang = pos[:, None] * inv[None, :]
    cos = jnp.cos(ang)[None, :, None, :]
    sin = jnp.sin(ang)[None, :, None, :]
    x1, x2 = x[..., :half], x[..., half:]
    return jnp.concatenate([x1 * cos - x2 * sin, x1 * sin + x2 * cos], axis=-1)


def retention_chunkwise(q, k, v):
    bsz, seqlen, nh, dk = q.shape
    dv = v.shape[-1]
    nc = seqlen // CHUNK
    log_gamma = jnp.log(1.0 - 2.0 ** (-5.0 - jnp.arange(nh, dtype=jnp.float32)))
    q = q.reshape(bsz, nc, CHUNK, nh, dk) * (dk ** -0.5)
    k = k.reshape(bsz, nc, CHUNK, nh, dk)
    v = v.reshape(bsz, nc, CHUNK, nh, dv)
    idx = jnp.arange(CHUNK, dtype=jnp.float32)
    diff = idx[:, None] - idx[None, :]
    causal = diff >= 0
    dmask = jnp.exp(jnp.where(causal[None], log_gamma[:, None, None] * diff[None], -jnp.inf))
    scores = jnp.einsum("bclhd,bcshd->bchls", q, k) * dmask[None, None]
    y_intra = jnp.einsum("bchls,bcshe->bclhe", scores, v)
    k_w = k * jnp.exp(log_gamma[None, :] * (CHUNK - 1.0 - idx)[:, None])[None, None, :, :, None]
    chunk_kv = jnp.einsum("bclhd,bclhe->bchde", k_w, v)
    chunk_decay = jnp.exp(log_gamma * CHUNK)[None, :, None, None]

    def step(state, kv):
        return state * chunk_decay + kv, state

    init = jnp.zeros((bsz, nh, dk, dv), jnp.float32)
    _, prev = lax.scan(step, init, jnp.moveaxis(chunk_kv, 1, 0))
    prev = jnp.moveaxis(prev, 0, 1)
    q_w = q * jnp.exp(log_gamma[None, :] * (idx + 1.0)[:, None])[None, None, :, :, None]
    y_inter = jnp.einsum("bclhd,bchde->bclhe", q_w, prev)
    return (y_intra + y_inter).reshape(bsz, seqlen, nh, dv)


def ssd_chunked(x, dt, a, bm, cm):
    bsz, seqlen, nh, p = x.shape
    ng, n = bm.shape[-2:]
    nj = nh // ng
    nc = seqlen // CHUNK
    xd = (x * dt[..., None]).reshape(bsz, nc, CHUNK, ng, nj, p)
    la = (dt * a).reshape(bsz, nc, CHUNK, ng, nj)
    la_cum = jnp.cumsum(la, axis=2)
    bc = bm.reshape(bsz, nc, CHUNK, ng, n)
    cc = cm.reshape(bsz, nc, CHUNK, ng, n)
    causal = jnp.tril(jnp.ones((CHUNK, CHUNK), bool))[None, None, :, :, None, None]
    seg = la_cum[:, :, :, None] - la_cum[:, :, None, :]
    lmat = jnp.exp(jnp.where(causal, seg, -jnp.inf))
    cb = jnp.einsum("bclgn,bcsgn->bclsg", cc, bc)
    y_diag = jnp.einsum("bclsgj,bcsgjp->bclgjp", cb[..., None] * lmat, xd)
    decay_to_end = jnp.exp(la_cum[:, :, -1:] - la_cum)
    chunk_states = jnp.einsum("bclgn,bclgj,bclgjp->bcgjpn", bc, decay_to_end, xd)
    chunk_decay = jnp.exp(la_cum[:, :, -1])

    def step(state, inp):
        s, d = inp
        return state * d[..., None, None] + s, state

    init = jnp.zeros((bsz, ng, nj, p, n), jnp.float32)
    _, prev = lax.scan(step, init, (jnp.moveaxis(chunk_states, 1, 0), jnp.moveaxis(chunk_decay, 1, 0)))
    prev = jnp.moveaxis(prev, 0, 1)
    y_off = jnp.einsum("bclgn,bcgjpn,bclgj->bclgjp", cc, prev, jnp.exp(la_cum))
    return (y_diag + y_off).reshape(bsz, seqlen, nh, p)


def gated_delta_chunked(q, k, v, g, beta):
    bsz, seqlen, nh, dk = q.shape
    dv = v.shape[-1]
    nc = seqlen // CHUNK

    def to_chunks(t):
        return t.reshape(bsz, nc, CHUNK, nh, t.shape[-1]).transpose(0, 3, 1, 2, 4)

    q = to_chunks(q * (dk ** -0.5))
    k = to_chunks(k)
    v = to_chunks(v)
    g = g.reshape(bsz, nc, CHUNK, nh).transpose(0, 3, 1, 2)
    beta = beta.reshape(bsz, nc, CHUNK, nh).transpose(0, 3, 1, 2)
    g_cum = jnp.cumsum(g, axis=-1)
    causal = jnp.tril(jnp.ones((CHUNK, CHUNK), bool))
    strict = jnp.tril(jnp.ones((CHUNK, CHUNK), bool), k=-1)
    decay = jnp.exp(jnp.where(causal, g_cum[..., :, None] - g_cum[..., None, :], -jnp.inf))
    k_beta = k * beta[..., None]
    v_beta = v * beta[..., None]
    lower = jnp.where(strict, jnp.einsum("bhcld,bhcsd->bhcls", k_beta, k) * decay, 0.0)
    eye = jnp.eye(CHUNK, dtype=jnp.float32)
    t_inv = lax.linalg.triangular_solve(eye + lower, jnp.broadcast_to(eye, lower.shape),
                                        left_side=True, lower=True)
    u = t_inv @ v_beta
    w = t_inv @ (k_beta * jnp.exp(g_cum)[..., None])
    attn = jnp.where(causal, jnp.einsum("bhcld,bhcsd->bhcls", q, k) * decay, 0.0)
    q_g = q * jnp.exp(g_cum)[..., None]
    k_tail = k * jnp.exp(g_cum[..., -1:] - g_cum)[..., None]
    chunk_decay = jnp.exp(g_cum[..., -1])

    def step(s, inp):
        q_i, w_i, u_i, a_i, kt_i, d_i = inp
        v_new = u_i - w_i @ s
        o = q_i @ s + a_i @ v_new
        s = s * d_i[..., None, None] + jnp.einsum("bhcd,bhce->bhde", kt_i, v_new)
        return s, o

    xs = tuple(jnp.moveaxis(t, 2, 0) for t in (q_g, w, u, attn, k_tail, chunk_decay))
    init = jnp.zeros((bsz, nh, dk, dv), jnp.float32)
    _, o = lax.scan(step, init, xs)
    return o.transpose(1, 0, 3, 2, 4).reshape(bsz, seqlen, nh, dv)


def s5_group_ssm(u, a_re, a_im, log_step, b_re, b_im, c_re, c_im, d_skip, w_glu, b_glu):
    f32 = jnp.float32
    bsz, seqlen, _ = u.shape
    ug = u.reshape(bsz, seqlen, S5_GROUPS, S5_GROUP)
    lam = lax.complex(a_re.astype(f32), a_im.astype(f32))
    step = jnp.exp(log_step.astype(f32))[:, None]
    lam_bar = jnp.exp(lam * step)
    b_mat = lax.complex(b_re.astype(f32), b_im.astype(f32))
    b_bar = ((lam_bar - 1.0) / lam)[..., None] * b_mat
    bu = jnp.einsum("blgc,gnc->blgn", ug.astype(jnp.complex64), b_bar)
    a_seq = jnp.broadcast_to(lam_bar, bu.shape)

    def combine(left, right):
        a_l, b_l = left
        a_r, b_r = right
        return a_r * a_l, a_r * b_l + b_r

    _, h = lax.associative_scan(combine, (a_seq, bu), axis=1)
    c_mat = lax.complex(c_re.astype(f32), c_im.astype(f32))
    y = jnp.einsum("blgn,gcn->blgc", h, c_mat).real + d_skip.astype(f32).reshape(S5_GROUPS, S5_GROUP) * ug
    y = jax.nn.gelu(y.reshape(bsz, seqlen, S5_CH))
    return y * jax.nn.sigmoid(y @ w_glu.astype(f32) + b_glu.astype(f32))


def retention_ssd_mixer(h, w_in, ssd_conv_w, ssd_conv_b, ssd_dt_bias, ssd_A_log, ssd_D, ssd_norm_w, w_out):
    f32 = jnp.float32
    bsz, seqlen, _ = h.shape
    proj = h @ w_in
    offs = np.cumsum([RET_QK_W, RET_QK_W, RET_V_W, RET_V_W, SSD_INNER, SSD_XBC_W]).tolist()
    q, k, v, gate, z, xbc, dt = jnp.split(proj, offs, axis=-1)
    pos = jnp.arange(seqlen, dtype=f32)
    q = rotary(q.astype(f32).reshape(bsz, seqlen, RET_HEADS, RET_DK), pos)
    k = rotary(k.astype(f32).reshape(bsz, seqlen, RET_HEADS, RET_DK), pos)
    v = v.astype(f32).reshape(bsz, seqlen, RET_HEADS, RET_DV)
    r = unit_rms(retention_chunkwise(q, k, v)).reshape(bsz, seqlen, RET_V_W)
    ret_out = jax.nn.silu(gate.astype(f32)) * r
    xbc = jax.nn.silu(causal_dwconv(xbc, ssd_conv_w) + ssd_conv_b.astype(xbc.dtype)).astype(f32)
    xs, bm, cm = jnp.split(xbc, [SSD_INNER, SSD_INNER + SSD_GROUPS * SSD_STATE], axis=-1)
    dt = jax.nn.softplus(dt.astype(f32) + ssd_dt_bias.astype(f32))
    a = -jnp.exp(ssd_A_log.astype(f32))
    xs = xs.reshape(bsz, seqlen, SSD_HEADS, SSD_HEAD_DIM)
    y = ssd_chunked(xs, dt, a, bm.reshape(bsz, seqlen, SSD_GROUPS, SSD_STATE),
                    cm.reshape(bsz, seqlen, SSD_GROUPS, SSD_STATE))
    y = (y + ssd_D.astype(f32)[:, None] * xs).reshape(bsz, seqlen, SSD_INNER)
    yg = (y * jax.nn.silu(z.astype(f32))).reshape(bsz, seqlen, SSD_GROUPS, SSD_INNER // SSD_GROUPS)
    ssd_out = unit_rms(yg).reshape(bsz, seqlen, SSD_INNER) * ssd_norm_w.astype(f32)
    mixed = jnp.concatenate([ret_out, ssd_out], axis=-1).astype(h.dtype)
    return mixed @ w_out


def deltanet_s5_mixer(h, w_in, gdn_conv_w, gdn_A_log, gdn_dt_bias, gdn_norm_w,
                      s5_A_re, s5_A_im, s5_log_step, s5_B_re, s5_B_im, s5_C_re, s5_C_im,
                      s5_D, s5_w_glu, s5_b_glu, w_out):
    f32 = jnp.float32
    bsz, seqlen, _ = h.shape
    proj = h @ w_in
    offs = np.cumsum([GDN_QKV_W, GDN_V_W, GDN_HEADS, GDN_HEADS]).tolist()
    qkv, z, b_raw, a_raw, u = jnp.split(proj, offs, axis=-1)
    qkv = jax.nn.silu(causal_dwconv(qkv, gdn_conv_w)).astype(f32)
    q, k, v = jnp.split(qkv, [GDN_QK_W, 2 * GDN_QK_W], axis=-1)
    q = l2norm(q.reshape(bsz, seqlen, GDN_HEADS, GDN_DK))
    k = l2norm(k.reshape(bsz, seqlen, GDN_HEADS, GDN_DK))
    v = v.reshape(bsz, seqlen, GDN_HEADS, GDN_DV)
    beta = jax.nn.sigmoid(b_raw.astype(f32))
    g = -jnp.exp(gdn_A_log.astype(f32)) * jax.nn.softplus(a_raw.astype(f32) + gdn_dt_bias.astype(f32))
    o = gated_delta_chunked(q, k, v, g, beta)
    o = unit_rms(o) * gdn_norm_w.astype(f32) * jax.nn.silu(z.astype(f32).reshape(bsz, seqlen, GDN_HEADS, GDN_DV))
    gdn_out = o.reshape(bsz, seqlen, GDN_V_W)
    s5_out = s5_group_ssm(u.astype(f32), s5_A_re, s5_A_im, s5_log_step, s5_B_re, s5_B_im,
                          s5_C_re, s5_C_im, s5_D, s5_w_glu, s5_b_glu)
    mixed = jnp.concatenate([gdn_out, s5_out], axis=-1).astype(h.dtype)
    return mixed @ w_out


def sqrelu_mlp(h, w_up, w_down):
    a = jax.nn.relu(h @ w_up)
    return (a * a) @ w_down


def setup_inputs(seed: int = 0) -> dict:
    key = jax.random.key(seed)
    ks = jax.random.split(key, 34)
    f32 = jnp.float32

    def nrm(i, shape, scale):
        return scale * jax.random.normal(ks[i], shape, f32)

    def gain(i, n):
        return 1.0 + nrm(i, (n,), 0.02)

    def dt_bias(i, n):
        dt = jnp.exp(jax.random.uniform(ks[i], (n,), f32, math.log(1e-3), math.log(1e-1)))
        return dt + jnp.log(-jnp.expm1(-dt))

    def a_log(i, n):
        return jnp.log(jax.random.uniform(ks[i], (n,), f32, 1.0, 16.0))

    dm = D_MODEL ** -0.5
    return {
        "x": nrm(0, (BATCH, SEQ, D_MODEL), 1.0),
        "l0_norm_mix": gain(1, D_MODEL),
        "l0_w_in": nrm(2, (D_MODEL, IN0_W), dm),
        "ssd_conv_w": nrm(3, (CONV_WIDTH, SSD_XBC_W), CONV_WIDTH ** -0.5),
        "ssd_conv_b": nrm(4, (SSD_XBC_W,), 0.02),
        "ssd_dt_bias": dt_bias(5, SSD_HEADS),
        "ssd_A_log": a_log(6, SSD_HEADS),
        "ssd_D": gain(7, SSD_HEADS),
        "ssd_norm_w": gain(8, SSD_INNER),
        "l0_w_out": nrm(9, (MIX0_W, D_MODEL), MIX0_W ** -0.5),
        "l0_norm_mlp": gain(10, D_MODEL),
        "l0_w_up": nrm(11, (D_MODEL, D_FF), dm),
        "l0_w_down": nrm(12, (D_FF, D_MODEL), D_FF ** -0.5),
        "l1_norm_mix": gain(13, D_MODEL),
        "l1_w_in": nrm(14, (D_MODEL, IN1_W), dm),
        "gdn_conv_w": nrm(15, (CONV_WIDTH, GDN_QKV_W), CONV_WIDTH ** -0.5),
        "gdn_A_log": a_log(16, GDN_HEADS),
        "gdn_dt_bias": dt_bias(17, GDN_HEADS),
        "gdn_norm_w": gain(18, GDN_DV),
        "s5_A_re": -0.5 + nrm(19, (S5_GROUPS, S5_STATE), 0.01),
        "s5_A_im": math.pi * jnp.arange(S5_STATE, dtype=f32)[None, :] + nrm(20, (S5_GROUPS, S5_STATE), 0.01),
        "s5_log_step": jax.random.uniform(ks[21], (S5_GROUPS,), f32, math.log(1e-3), math.log(1e-1)),
        "s5_B_re": nrm(22, (S5_GROUPS, S5_STATE, S5_GROUP), (2 * S5_GROUP) ** -0.5),
        "s5_B_im": nrm(23, (S5_GROUPS, S5_STATE, S5_GROUP), (2 * S5_GROUP) ** -0.5),
        "s5_C_re": nrm(24, (S5_GROUPS, S5_GROUP, S5_STATE), (2 * S5_STATE) ** -0.5),
        "s5_C_im": nrm(25, (S5_GROUPS, S5_GROUP, S5_STATE), (2 * S5_STATE) ** -0.5),
        "s5_D": nrm(26, (S5_CH,), 1.0),
        "s5_w_glu": nrm(27, (S5_CH, S5_CH), S5_CH ** -0.5),
        "s5_b_glu": nrm(28, (S5_CH,), 0.02),
        "l1_w_out": nrm(29, (MIX1_W, D_MODEL), MIX1_W ** -0.5),
        "l1_norm_mlp": gain(30, D_MODEL),
        "l1_w_up": nrm(31, (D_MODEL, D_FF), dm),
        "l1_w_down": nrm(32, (D_FF, D_MODEL), D_FF ** -0.5),
        "final_norm": gain(33, D_MODEL),
    }


def reference(x, l0_norm_mix, l0_w_in, ssd_conv_w, ssd_conv_b, ssd_dt_bias, ssd_A_log, ssd_D,
              ssd_norm_w, l0_w_out, l0_norm_mlp, l0_w_up, l0_w_down, l1_norm_mix, l1_w_in,
              gdn_conv_w, gdn_A_log, gdn_dt_bias, gdn_norm_w, s5_A_re, s5_A_im, s5_log_step,
              s5_B_re, s5_B_im, s5_C_re, s5_C_im, s5_D, s5_w_glu, s5_b_glu, l1_w_out,
              l1_norm_mlp, l1_w_up, l1_w_down, final_norm):
    for layer in range(DEPTH):
        if layer % 2 == 0:
            x = x + retention_ssd_mixer(rmsnorm(x, l0_norm_mix), l0_w_in, ssd_conv_w, ssd_conv_b,
                                        ssd_dt_bias, ssd_A_log, ssd_D, ssd_norm_w, l0_w_out)
            x = x + sqrelu_mlp(rmsnorm(x, l0_norm_mlp), l0_w_up, l0_w_down)
        else:
            x = x + deltanet_s5_mixer(rmsnorm(x, l1_norm_mix), l1_w_in, gdn_conv_w, gdn_A_log,
                                      gdn_dt_bias, gdn_norm_w, s5_A_re, s5_A_im, s5_log_step,
                                      s5_B_re, s5_B_im, s5_C_re, s5_C_im, s5_D, s5_w_glu,
                                      s5_b_glu, l1_w_out)
            x = x + sqrelu_mlp(rmsnorm(x, l1_norm_mlp), l1_w_up, l1_w_down)
    return rmsnorm(x, final_norm)
```

```cpp
#ifndef CPU_EMU
#include <hip/hip_runtime.h>
#include <hip/hip_cooperative_groups.h>
#include <cstdio>
#define LAS __attribute__((address_space(3)))
#define GLDS16(g, l) __builtin_amdgcn_global_load_lds((const unsigned*)(g), (LAS unsigned*)(l), 16, 0, 0)
#define WAIT_V(n) asm volatile("s_waitcnt vmcnt(" #n ")" ::: "memory")
#define WAIT_L(n) asm volatile("s_waitcnt lgkmcnt(" #n ")" ::: "memory")
#else
#define LAS
#define GLDS16(g, l) memcpy((unsigned char*)(l) + 16 * (threadIdx.x & 63), (const void*)(g), 16)
#define WAIT_V(n) emu::wave_barrier()
#define WAIT_L(n) emu::wave_barrier()
#endif
namespace cg = cooperative_groups;
#define DI __device__ __forceinline__

#ifndef SEQ_LEN
#define SEQ_LEN 16384
#endif
#ifndef N_LAUNCH_MODE
#define N_LAUNCH_MODE 0
#endif

typedef unsigned short bf16_t;
typedef short bf16x8 __attribute__((ext_vector_type(8)));
typedef float f32x4 __attribute__((ext_vector_type(4)));
typedef float f32x2 __attribute__((ext_vector_type(2)));
typedef unsigned u32x4 __attribute__((ext_vector_type(4)));
typedef unsigned u32x2 __attribute__((ext_vector_type(2)));

constexpr int BATCH = 2, L = SEQ_LEN, T = BATCH * L, NCHT = T / 64  , D = 1024, DFF = 4096;
constexpr int N0 = 3584;
constexpr int N0SRC = 3592;
constexpr int N1 = 3328;
constexpr int N1SRC = 3340;
constexpr float EPS = 1e-6f;
constexpr int NTHREADS = 512, LDS_BYTES = 147456;

constexpr size_t MiB = 1u << 20;
constexpr size_t WS_CTL = 0;
constexpr size_t WS_W_IN0 = 1 * MiB, WS_W_OUT0 = WS_W_IN0 + (size_t)N0 * D * 2, WS_W_UP0 = WS_W_OUT0 + (size_t)D * D * 2, WS_W_DN0 = WS_W_UP0 + (size_t)DFF * D * 2,
                 WS_W_IN1 = WS_W_DN0 + (size_t)D * DFF * 2, WS_W_OUT1 = WS_W_IN1 + (size_t)N1 * D * 2, WS_W_UP1 = WS_W_OUT1 + (size_t)D * D * 2, WS_W_DN1 = WS_W_UP1 + (size_t)DFF * D * 2,
                 WS_W_END = WS_W_DN1 + (size_t)D * DFF * 2;
static_assert(WS_W_END <= 52 * MiB, "weights");
constexpr size_t WS_ROPE = 52 * MiB;
constexpr size_t WS_S5C = WS_ROPE + (size_t)L * 64 * 8;
constexpr size_t WS_WDT = WS_S5C + 16 * 64 * 8 + 16 * 64 * 16 * 8;
constexpr size_t WS_SMALL = ((WS_WDT + 1024 * 8 * 4 + 4095) / 4096) * 4096;
constexpr size_t WS_DT = WS_SMALL;
constexpr size_t WS_BG = WS_DT + (size_t)T * 8 * 4;
constexpr size_t WS_LAC = WS_BG + (size_t)T * 16 * 4;
constexpr size_t WS_GC = WS_LAC + (size_t)T * 8 * 4;
constexpr size_t WS_SSQ = WS_GC + (size_t)T * 8 * 4;
constexpr size_t WS_XN = ((WS_SSQ + (size_t)T * 16 * 4 + MiB - 1) / MiB) * MiB;
constexpr size_t WS_MIX = WS_XN + (size_t)T * D * 2;
constexpr size_t WS_PROJ = WS_MIX + (size_t)T * D * 2;
constexpr size_t WS_TAIL = WS_PROJ + (size_t)T * DFF * 2;
constexpr size_t WS_END = WS_TAIL + (size_t)T * 1536;
static_assert(SEQ_LEN != 16384 || WS_END <= 512 * MiB, "workspace");

struct Params { const float* in[34]; float* out; unsigned char* ws; int ph_lo, ph_hi; };

DI float bf2f(bf16_t b) { return __uint_as_float(((unsigned)b) << 16); }
DI bf16_t f2bf(float f) { unsigned u = __float_as_uint(f); return (bf16_t)((u + 0x7fffu + ((u >> 16) & 1u)) >> 16); }
DI unsigned pk2(float lo, float hi) { return (unsigned)f2bf(lo) | ((unsigned)f2bf(hi) << 16); }
#ifndef CPU_EMU
DI unsigned cvt_pk_bf16(float lo, float hi) { unsigned r; asm volatile("v_cvt_pk_bf16_f32 %0, %1, %2" : "=v"(r) : "v"(lo), "v"(hi)); return r; }
#else
DI unsigned cvt_pk_bf16(float lo, float hi) { return pk2(lo, hi); }
#endif
DI float silu_f(float x) { return x / (1.0f + expf(-x)); }
DI float sigmoid_f(float x) { return 1.0f / (1.0f + expf(-x)); }
DI float softplus_f(float x) { return x > 20.0f ? x : log1pf(expf(x)); }
DI float gelu_tanh_f(float x) { return 0.5f * x * (1.0f + tanhf(0.7978845608028654f * (x + 0.044715f * x * x * x))); }
DI float wave_sum(float v) {
#pragma unroll
    for (int o = 1; o < 64; o <<= 1) v += __shfl_xor(v, o);
    return v;
}
DI void sincos_rev(double rev, double& s, double& c) {
    const double fr = rev - rint(rev); const double q = rint(fr * 4.0); const double r = (fr - q * 0.25) * 6.283185307179586476925; const double r2 = r * r;
    const double sr = r * (1.0 + r2 * (-1.0 / 6.0 + r2 * (1.0 / 120.0 + r2 * (-1.0 / 5040.0 + r2 * (1.0 / 362880.0 + r2 * (-1.0 / 39916800.0 + r2 * (1.0 / 6227020800.0)))))));
    const double cr = 1.0 + r2 * (-0.5 + r2 * (1.0 / 24.0 + r2 * (-1.0 / 720.0 + r2 * (1.0 / 40320.0 + r2 * (-1.0 / 3628800.0 + r2 * (1.0 / 479001600.0 + r2 * (-1.0 / 87178291200.0)))))));
    const int qi = ((int)q) & 3;
    s = qi == 0 ? sr : qi == 1 ? cr : qi == 2 ? -sr : -cr;
    c = qi == 0 ? cr : qi == 1 ? -sr : qi == 2 ? -cr : sr;
}

namespace pg8 {
constexpr int BM = 256, BK = 64, HALF = 128, HTB = HALF * BK * 2, STAGE_BYTES = 8 * HTB, NXCD = 8, WGM = 8;
DI int lds_byte(int r, int c) { const int st = (r >> 4) * 2 + (c >> 5), rr = r & 15, cc = c & 31, ob = rr * 64 + cc * 2; return st * 1024 + (ob ^ (((ob >> 9) & 1) << 5)); }
DI void stage_rc(int b, int& R, int& C) { const int st = b / 1024, sb = b % 1024, swz = sb ^ (((sb >> 9) & 1) << 5); R = (st >> 1) * 16 + swz / 64; C = (st & 1) * 32 + (swz % 64) / 2; }
DI int perm32(int rho) { const int n = rho >> 4, i = rho & 15; return 8 * (i >> 2) + 4 * n + (i & 3); }
struct Unit { int pm, pn; };
struct Gemm { const bf16_t* A; const bf16_t* Bt; int M, N, K; };
struct StaticOrder {
    int nM, nN, nwg, G, c;
    DI void init(int M, int N, int G_, int c_) { nM = M / BM; nN = N / BM; nwg = nM * nN; G = G_; c = c_; }
    DI bool next(int i, Unit& u) const {
        const long Lx = (long)i * G + c; if (Lx >= nwg) return false;
        int wgid = (int)Lx; { const int q = nwg / NXCD, r = nwg % NXCD, xcd = wgid % NXCD, off = wgid / NXCD; wgid = (xcd < r ? xcd * (q + 1) : r * (q + 1) + (xcd - r) * q) + off; }
        const int nig = WGM * nN, gid = wgid / nig, fm = gid * WGM, gsz = (nM - fm) < WGM ? (nM - fm) : WGM;
        u.pm = fm + ((wgid % nig) % gsz); u.pn = (wgid % nig) / gsz; return true;
    }
};
DI float row_rs(const float* ssq, int row) {
    const f32x4* p = (const f32x4*)(ssq + (size_t)row * 16); const f32x4 a = p[0], b = p[1], c = p[2], d = p[3];
    const float s = ((a[0] + a[1]) + (a[2] + a[3])) + ((b[0] + b[1]) + (b[2] + b[3])) + ((c[0] + c[1]) + (c[2] + c[3])) + ((d[0] + d[1]) + (d[2] + d[3]));
    return 1.0f / sqrtf(s * (1.0f / 1024.0f) + EPS);
}
struct EpiProj {
    static constexpr bool PERM = true;
    bf16_t* O; int ldc; const float* ssq; int act;
    DI void operator()(const f32x4 (&acc)[2][2][4][2], const Unit& u, int wr, int wc, int fr, int fq) const {
        const int row0 = u.pm * BM + wr * 64 + fr, col0 = u.pn * BM + wc * 32 + 8 * fq;
#pragma unroll
        for (int ai = 0; ai < 2; ++ai)
#pragma unroll
            for (int m = 0; m < 4; ++m) { const int row = row0 + ai * HALF + m * 16; const float rs = ssq ? row_rs(ssq, row) : 1.0f; bf16_t* rowp = O + (size_t)row * ldc + col0;
#pragma unroll
                for (int bj = 0; bj < 2; ++bj) { f32x4 v0 = acc[ai][bj][m][0] * rs, v1 = acc[ai][bj][m][1] * rs;
                    if (act == 1) {
#pragma unroll
                        for (int j = 0; j < 4; ++j) { const float a0 = v0[j] > 0.f ? v0[j] : 0.f, a1 = v1[j] > 0.f ? v1[j] : 0.f; v0[j] = a0 * a0; v1[j] = a1 * a1; } }
                    u32x4 w; w.x = cvt_pk_bf16(v0[0], v0[1]); w.y = cvt_pk_bf16(v0[2], v0[3]); w.z = cvt_pk_bf16(v1[0], v1[1]); w.w = cvt_pk_bf16(v1[2], v1[3]);
                    *(u32x4*)(rowp + bj * HALF) = w; } }
    }
};
struct EpiResid {
    static constexpr bool PERM = false;
    const float* base; float* out; bf16_t* xn; float* ssq;
    DI void operator()(const f32x4 (&acc)[2][2][4][2], const Unit& u, int wr, int wc, int fr, int fq) const {
        const int row0 = u.pm * BM + wr * 64 + fr, col0 = u.pn * BM + wc * 32 + 4 * fq;
#pragma unroll
        for (int ai = 0; ai < 2; ++ai)
#pragma unroll
            for (int m = 0; m < 4; ++m) { const int row = row0 + ai * HALF + m * 16; const size_t off = (size_t)row * D + col0; float ss = 0.f;
#pragma unroll
                for (int bj = 0; bj < 2; ++bj)
#pragma unroll
                    for (int n = 0; n < 2; ++n) { const size_t o2 = off + bj * HALF + n * 16; const f32x4 b = *(const f32x4*)(base + o2); const f32x4 o = b + acc[ai][bj][m][n];
                        *(f32x4*)(out + o2) = o; ss += (o[0] * o[0] + o[1] * o[1]) + (o[2] * o[2] + o[3] * o[3]);
                        u32x2 w; w.x = cvt_pk_bf16(o[0], o[1]); w.y = cvt_pk_bf16(o[2], o[3]); *(u32x2*)(xn + o2) = w; }
                ss += __shfl_xor(ss, 16); ss += __shfl_xor(ss, 32);
                if (fq == 0) ssq[(size_t)row * 16 + u.pn * 4 + wc] = ss; }
    }
};

template <class Epi>
DI void gemm_phase(LAS unsigned char* lds, const Gemm g, const StaticOrder& S, const Epi& E) {
    const int tid = threadIdx.x, wid = __builtin_amdgcn_readfirstlane(tid >> 6), lane = tid & 63, wr = wid >> 2, wc = wid & 3, fr = lane & 15, fq = lane >> 4;
    const int K = g.K, nt = K / BK;
    unsigned voffA[2], voffB[2];
#pragma unroll
    for (int i = 0; i < 2; ++i) { int R, C; stage_rc(tid * 16 + i * 8192, R, C); const int Rb = Epi::PERM ? ((R & ~31) + perm32(R & 31)) : R;
        voffA[i] = (unsigned)(R * K + C) * 2u; voffB[i] = (unsigned)(Rb * K + C) * 2u; }
    const size_t kstep = (size_t)(BK * 2);
    const size_t hstep = (size_t)HALF * K * 2;
    const size_t tstep = 2 * hstep;
    const unsigned ldsw = (unsigned)wid * 1024u;
    const int aoff = lds_byte(wr * 64 + fr, fq * 8), boff = lds_byte(wc * 32 + fr, fq * 8);
#define PG8_SA(b, h) (((b) * 2 + (h)) * HTB)
#define PG8_SB(b, h) ((4 + (b) * 2 + (h)) * HTB)
#define PG8_STAGE(bufoff, gbase, voff) do { _Pragma("unroll") for (int _i = 0; _i < 2; ++_i) \
        GLDS16((const char*)(gbase) + (voff)[_i], lds + (bufoff) + ldsw + _i * 8192); } while (0)
#define PG8_LDA(dst, b, h) do { _Pragma("unroll") for (int m = 0; m < 4; ++m) _Pragma("unroll") for (int k = 0; k < 2; ++k) dst[m][k] = *(const LAS bf16x8*)(lds + PG8_SA(b, h) + aoff + m * 2048 + k * 1024); } while (0)
#define PG8_LDB(dst, b, h) do { _Pragma("unroll") for (int n = 0; n < 2; ++n) _Pragma("unroll") for (int k = 0; k < 2; ++k) dst[n][k] = *(const LAS bf16x8*)(lds + PG8_SB(b, h) + boff + n * 2048 + k * 1024); } while (0)
#define PG8_MMA(ai, bj, At, Bt) do { __builtin_amdgcn_s_setprio(1); _Pragma("unroll") for (int m = 0; m < 4; ++m) _Pragma("unroll") for (int n = 0; n < 2; ++n) _Pragma("unroll") for (int k = 0; k < 2; ++k) \
        acc[ai][bj][m][n] = __builtin_amdgcn_mfma_f32_16x16x32_bf16(Bt[n][k], At[m][k], acc[ai][bj][m][n], 0, 0, 0); __builtin_amdgcn_s_setprio(0); } while (0)
#define PG8_BAR __builtin_amdgcn_s_barrier()
#define PG8_SCHED __builtin_amdgcn_sched_barrier(0)
    Unit cur, nxt; int ui = 0;
    if (!S.next(0, cur)) return;
    f32x4 acc[2][2][4][2];
#pragma unroll
    for (int a = 0; a < 2; ++a)
#pragma unroll
        for (int b = 0; b < 2; ++b)
#pragma unroll
            for (int m = 0; m < 4; ++m)
#pragma unroll
                for (int n = 0; n < 2; ++n) acc[a][b][m][n] = (f32x4){0.f, 0.f, 0.f, 0.f};
    bf16x8 At[4][2], B0[2][2], B1[2][2];
    const char* cA = (const char*)g.A + (size_t)cur.pm * tstep; const char* cB = (const char*)g.Bt + (size_t)cur.pn * tstep;
    PG8_STAGE(PG8_SB(0, 0), cB, voffB); PG8_STAGE(PG8_SA(0, 0), cA, voffA); PG8_STAGE(PG8_SB(0, 1), cB + hstep, voffB); PG8_STAGE(PG8_SA(0, 1), cA + hstep, voffA);
    if (wr == 1) PG8_BAR;
    WAIT_V(4); PG8_BAR;
    PG8_STAGE(PG8_SB(1, 0), cB + kstep, voffB); PG8_STAGE(PG8_SA(1, 0), cA + kstep, voffA); PG8_STAGE(PG8_SB(1, 1), cB + hstep + kstep, voffB);
    WAIT_V(6); PG8_BAR;
    for (;;) {
        const bool has_next = S.next(ui + 1, nxt);
        const char* nA = has_next ? (const char*)g.A + (size_t)nxt.pm * tstep : cA; const char* nB = has_next ? (const char*)g.Bt + (size_t)nxt.pn * tstep : cB;
        for (int t = 0; t < nt; t += 2) {
            const bool last = (t == nt - 2);
            const char* a1 = cA + (size_t)(t + 1) * kstep;
            const char* a2 = last ? nA : cA + (size_t)(t + 2) * kstep; const char* b2 = last ? nB : cB + (size_t)(t + 2) * kstep;
            const char* a3 = a2 + kstep; const char* b3 = b2 + kstep;
            PG8_LDB(B0, 0, 0); PG8_SCHED; PG8_LDA(At, 0, 0); PG8_STAGE(PG8_SA(1, 1), a1 + hstep, voffA);
            WAIT_L(8); PG8_BAR; WAIT_L(0); PG8_MMA(0, 0, At, B0); PG8_BAR; PG8_SCHED;
            PG8_LDB(B1, 0, 1); PG8_STAGE(PG8_SB(0, 0), b2, voffB);
            PG8_BAR; WAIT_L(0); PG8_MMA(0, 1, At, B1); PG8_BAR;
            PG8_LDA(At, 0, 1); PG8_STAGE(PG8_SA(0, 0), a2, voffA);
            PG8_BAR; WAIT_L(0); PG8_MMA(1, 0, At, B0); PG8_BAR; PG8_SCHED;
            PG8_STAGE(PG8_SB(0, 1), b2 + hstep, voffB);
            WAIT_V(6); PG8_BAR; PG8_MMA(1, 1, At, B1); PG8_BAR;
            PG8_LDB(B0, 1, 0); PG8_SCHED; PG8_LDA(At, 1, 0); PG8_STAGE(PG8_SA(0, 1), a2 + hstep, voffA);
            WAIT_L(8); PG8_BAR; WAIT_L(0); PG8_MMA(0, 0, At, B0); PG8_BAR; PG8_SCHED;
            PG8_LDB(B1, 1, 1); PG8_STAGE(PG8_SB(1, 0), b3, voffB);
            PG8_BAR; WAIT_L(0); PG8_MMA(0, 1, At, B1); PG8_BAR;
            PG8_LDA(At, 1, 1); PG8_STAGE(PG8_SA(1, 0), a3, voffA);
            PG8_BAR; WAIT_L(0); PG8_MMA(1, 0, At, B0); PG8_BAR; PG8_SCHED;
            PG8_STAGE(PG8_SB(1, 1), b3 + hstep, voffB);
            WAIT_V(6); PG8_BAR; PG8_MMA(1, 1, At, B1); PG8_BAR;
        }
        E(acc, cur, wr, wc, fr, fq);
        if (!has_next) break;
#pragma unroll
        for (int a = 0; a < 2; ++a)
#pragma unroll
            for (int b = 0; b < 2; ++b)
#pragma unroll
                for (int m = 0; m < 4; ++m)
#pragma unroll
                    for (int n = 0; n < 2; ++n) acc[a][b][m][n] = (f32x4){0.f, 0.f, 0.f, 0.f};
        cur = nxt; cA = nA; cB = nB; ++ui;
    }
    WAIT_V(0);
    if (wr == 0) PG8_BAR;
    PG8_BAR;
#undef PG8_SA
#undef PG8_SB
#undef PG8_STAGE
#undef PG8_LDA
#undef PG8_LDB
#undef PG8_MMA
#undef PG8_BAR
#undef PG8_SCHED
}
}

struct Frame {
    LAS unsigned char* lds; int tid, lane, wave, G; long gtid, gthreads; int gwave, gwaves;
    const float* const* in; float* out; unsigned char* ws;
};
#define WSP(type, off) ((type*)(F.ws + (off)))

DI void p0_transpose_item(const float* W, int K, int Nsrc, int N, const float* scale, int split, int gap, bf16_t* WT, LAS float* scr, int item, int lane) {
    const int nblk = N / 32, kb = item / nblk, nb = item % nblk, k0 = 64 * kb, n0 = 32 * nb, s0 = n0 + (n0 >= split ? gap : 0);
#pragma unroll 8
    for (int i = 0; i < 32; ++i) { const int kk = 2 * i + (lane >> 5); scr[kk * 33 + (lane & 31)] = W[(size_t)(k0 + kk) * Nsrc + s0 + (lane & 31)] * (scale ? scale[k0 + kk] : 1.0f); }
    WAIT_L(0); asm volatile("" ::: "memory");
    const int c = lane & 7;
#pragma unroll
    for (int j = 0; j < 4; ++j) { const int n = (lane >> 3) + 8 * j; const LAS float* s = scr + (8 * c) * 33 + n;
        u32x4 o; o.x = pk2(s[0 * 33], s[1 * 33]); o.y = pk2(s[2 * 33], s[3 * 33]); o.z = pk2(s[4 * 33], s[5 * 33]); o.w = pk2(s[6 * 33], s[7 * 33]);
        *(u32x4*)(WT + (size_t)(n0 + n) * K + k0 + 8 * c) = o; }
    WAIT_L(0); asm volatile("" ::: "memory");
}
DI void p0_prologue(Frame& F) {
    LAS float* scr = (LAS float*)(F.lds + F.wave * 16384);
    constexpr int I_IN0 = (D / 64) * (N0 / 32), I_SQ = (D / 64) * (D / 32), I_UP = (D / 64) * (DFF / 32), I_DN = (DFF / 64) * (D / 32), I_IN1 = (D / 64) * (N1 / 32);
    constexpr int NITEMS = I_IN0 + I_IN1 + 2 * (I_SQ + I_UP + I_DN);
    for (int it = F.gwave; it < NITEMS; it += F.gwaves) {
        int r = it;
        if (r < I_IN0) { p0_transpose_item(F.in[2], D, N0SRC, N0, F.in[1], 1 << 30, 0, WSP(bf16_t, WS_W_IN0), scr, r, F.lane); continue; } r -= I_IN0;
        if (r < I_SQ) { p0_transpose_item(F.in[9], D, D, D, nullptr, 1 << 30, 0, WSP(bf16_t, WS_W_OUT0), scr, r, F.lane); continue; } r -= I_SQ;
        if (r < I_UP) { p0_transpose_item(F.in[11], D, DFF, DFF, F.in[10], 1 << 30, 0, WSP(bf16_t, WS_W_UP0), scr, r, F.lane); continue; } r -= I_UP;
        if (r < I_DN) { p0_transpose_item(F.in[12], DFF, D, D, nullptr, 1 << 30, 0, WSP(bf16_t, WS_W_DN0), scr, r, F.lane); continue; } r -= I_DN;
        if (r < I_IN1) { p0_transpose_item(F.in[14], D, N1SRC, N1, F.in[13], 3072, 12, WSP(bf16_t, WS_W_IN1), scr, r, F.lane); continue; } r -= I_IN1;
        if (r < I_SQ) { p0_transpose_item(F.in[29], D, D, D, nullptr, 1 << 30, 0, WSP(bf16_t, WS_W_OUT1), scr, r, F.lane); continue; } r -= I_SQ;
        if (r < I_UP) { p0_transpose_item(F.in[31], D, DFF, DFF, F.in[30], 1 << 30, 0, WSP(bf16_t, WS_W_UP1), scr, r, F.lane); continue; } r -= I_UP;
        p0_transpose_item(F.in[32], DFF, D, D, nullptr, 1 << 30, 0, WSP(bf16_t, WS_W_DN1), scr, r, F.lane);
    }
    __syncthreads();
    LAS float* wdt = (LAS float*)F.lds;
    for (int i = F.tid; i < 1024 * 8; i += NTHREADS) { const int k = i >> 3, c = i & 7; wdt[i] = F.in[1][k] * F.in[2][(size_t)k * N0SRC + N0 + c]; }
    __syncthreads();
    for (int m = F.gwave; m < T; m += F.gwaves) {
        const f32x4* xr = (const f32x4*)(F.in[0] + (size_t)m * D) + F.lane;
        f32x4 v[4]; float s = 0.f;
#pragma unroll
        for (int j = 0; j < 4; ++j) { v[j] = xr[64 * j]; s += (v[j][0] * v[j][0] + v[j][1] * v[j][1]) + (v[j][2] * v[j][2] + v[j][3] * v[j][3]); }
        const float rs = 1.0f / sqrtf(wave_sum(s) * (1.0f / D) + EPS);
        float dacc[8];
#pragma unroll
        for (int c = 0; c < 8; ++c) dacc[c] = 0.f;
        unsigned long long* o8 = (unsigned long long*)(WSP(bf16_t, WS_XN) + (size_t)m * D) + F.lane;
#pragma unroll
        for (int j = 0; j < 4; ++j) {
            v[j] = v[j] * rs;
            o8[64 * j] = (unsigned long long)pk2(v[j][0], v[j][1]) | ((unsigned long long)pk2(v[j][2], v[j][3]) << 32);
#pragma unroll
            for (int e = 0; e < 4; ++e) { const LAS f32x4* wp = (const LAS f32x4*)(wdt + (size_t)(4 * F.lane + 256 * j + e) * 8); const f32x4 w0 = wp[0], w1 = wp[1];
#pragma unroll
                for (int c = 0; c < 4; ++c) { dacc[c] += v[j][e] * w0[c]; dacc[4 + c] += v[j][e] * w1[c]; } }
        }
#pragma unroll
        for (int c = 0; c < 8; ++c) dacc[c] = wave_sum(dacc[c]);
        float mine = 0.f;
#pragma unroll
        for (int c = 0; c < 8; ++c) mine = (F.lane == c) ? dacc[c] : mine;
        if (F.lane < 8) WSP(float, WS_DT)[(size_t)m * 8 + F.lane] = softplus_f(mine + F.in[5][F.lane]);
    }
    for (long i = F.gtid; i < (long)L * 64; i += F.gthreads) {
        const int fi = (int)(i & 63), t = (int)(i >> 6);
        double inv = 1.0;
        if (fi & 1) inv *= 0.86596432336006535; if (fi & 2) inv *= 0.74989420933245582; if (fi & 4) inv *= 0.56234132519034908;
        if (fi & 8) inv *= 0.31622776601683794; if (fi & 16) inv *= 0.1; if (fi & 32) inv *= 0.01;
        double s, c; sincos_rev((double)t * inv * 0.15915494309189533577, s, c);
        WSP(f32x2, WS_ROPE)[i] = (f32x2){(float)c, (float)s};
    }
    for (long i = F.gtid; i < 16 * 64; i += F.gthreads) {
        const int g = (int)(i >> 6);
        const double are = F.in[19][i], aim = F.in[20][i], step = exp((double)F.in[21][g]);
        const double mag = exp(are * step); double s, c; sincos_rev(aim * step * 0.15915494309189533577, s, c);
        const double lre = mag * c, lim = mag * s;
        WSP(f32x2, WS_S5C)[i] = (f32x2){(float)lre, (float)lim};
        const double nre = lre - 1.0, nim = lim, den = are * are + aim * aim;
        const double fre = (nre * are + nim * aim) / den, fim = (nim * are - nre * aim) / den;
        for (int c2 = 0; c2 < 16; ++c2) { const double bre = F.in[22][i * 16 + c2], bim = F.in[23][i * 16 + c2];
            WSP(f32x2, WS_S5C + 16 * 64 * 8)[i * 16 + c2] = (f32x2){(float)(fre * bre - fim * bim), (float)(fre * bim + fim * bre)}; }
    }
}

#define P0B WSP(bf16_t, WS_PROJ)
#define XBC WSP(bf16_t, WS_XN)
#define SCB WSP(float, WS_TAIL)
#define CBB WSP(float, WS_PROJ + (size_t)T * N0 * 2)
#define YRS (F.out)
DI float ret_log_gamma(int h) { return logf(1.0f - exp2f(-5.0f - (float)h)); }

DI void l0_level_a(Frame& F) {
    const f32x2* rope = WSP(f32x2, WS_ROPE);
    for (long idx = F.gtid; idx < (long)T * 512; idx += F.gthreads) {
        const int i = (int)(idx & 63), h = (int)((idx >> 6) & 3), which = (int)((idx >> 8) & 1); const long tok = idx >> 9; const int t = (int)(tok % L);
        bf16_t* p = P0B + (size_t)tok * N0 + which * 512 + h * 128 + i;
        const float x1 = bf2f(p[0]), x2 = bf2f(p[64]); const f32x2 cs = rope[(size_t)t * 64 + i]; const float sc = which == 0 ? 0.08838834764831845f : 1.0f;
        p[0] = f2bf((x1 * cs[0] - x2 * cs[1]) * sc); p[64] = f2bf((x1 * cs[1] + x2 * cs[0]) * sc);
    }
    for (long idx = F.gtid; idx < (long)T * 1024; idx += F.gthreads) {
        const int c = (int)(idx & 1023); const long tok = idx >> 10; const int t = (int)(tok % L);
        float a = F.in[4][c];
#pragma unroll
        for (int j = 0; j < 4; ++j) if (t - 3 + j >= 0) a += F.in[3][j * 1024 + c] * bf2f(P0B[(size_t)(tok - 3 + j) * N0 + 2560 + c]);
        XBC[(size_t)tok * 1024 + c] = f2bf(silu_f(a));
    }
    for (long idx = F.gtid; idx < (long)NCHT * 8; idx += F.gthreads) {
        const int h = (int)(idx & 7); const long ch = idx >> 3; const float a = -expf(F.in[6][h]); float run = 0.f;
        for (int l = 0; l < 64; ++l) { const size_t tok = (size_t)ch * 64 + l; run += WSP(float, WS_DT)[tok * 8 + h] * a; WSP(float, WS_LAC)[tok * 8 + h] = run; }
    }
}
DI void l0_level_b(Frame& F) {
    for (long idx = F.gtid; idx < (long)NCHT * 4 * 4096; idx += F.gthreads) {
        const int s = (int)(idx & 63), l = (int)((idx >> 6) & 63), h = (int)((idx >> 12) & 3); const long ch = idx >> 14;
        float v = 0.f;
        if (s <= l) { const bf16_t* q = P0B + (size_t)(ch * 64 + l) * N0 + h * 128; const bf16_t* k = P0B + (size_t)(ch * 64 + s) * N0 + 512 + h * 128;
            for (int d = 0; d < 128; ++d) v += bf2f(q[d]) * bf2f(k[d]);
            v *= expf(ret_log_gamma(h) * (float)(l - s)); }
        SCB[idx] = v;
    }
    for (long idx = F.gtid; idx < (long)NCHT * 2 * 4096; idx += F.gthreads) {
        const int s = (int)(idx & 63), l = (int)((idx >> 6) & 63), g = (int)((idx >> 12) & 1); const long ch = idx >> 13;
        float v = 0.f;
        if (s <= l) { const bf16_t* c = XBC + (size_t)(ch * 64 + l) * 1024 + 768 + g * 128; const bf16_t* b = XBC + (size_t)(ch * 64 + s) * 1024 + 512 + g * 128;
            for (int n = 0; n < 128; ++n) v += bf2f(c[n]) * bf2f(b[n]); }
        CBB[idx] = v;
    }
}
DI void l0_level_c(Frame& F) {
    for (long idx = F.gtid; idx < (long)T * 512; idx += F.gthreads) {
        const int e = (int)(idx & 127), h = (int)((idx >> 7) & 3); const long tok = idx >> 9, ch = tok >> 6; const int l = (int)(tok & 63);
        const float* sc = SCB + ((size_t)(ch * 4 + h) * 64 + l) * 64; float y = 0.f;
        for (int s = 0; s <= l; ++s) y += sc[s] * bf2f(P0B[(size_t)(ch * 64 + s) * N0 + 1024 + h * 128 + e]);
        YRS[(size_t)tok * 1024 + h * 128 + e] = y;
    }
    for (long idx = F.gtid; idx < (long)T * 512; idx += F.gthreads) {
        const int p = (int)(idx & 63), h = (int)((idx >> 6) & 7), g = h >> 2; const long tok = idx >> 9, ch = tok >> 6; const int l = (int)(tok & 63);
        const float* cb = CBB + ((size_t)(ch * 2 + g) * 64 + l) * 64; const float lal = WSP(float, WS_LAC)[(size_t)tok * 8 + h]; float y = 0.f;
        for (int s = 0; s <= l; ++s) { const size_t ts = (size_t)ch * 64 + s;
            y += cb[s] * expf(lal - WSP(float, WS_LAC)[ts * 8 + h]) * bf2f(XBC[ts * 1024 + h * 64 + p]) * WSP(float, WS_DT)[ts * 8 + h]; }
        YRS[(size_t)tok * 1024 + 512 + h * 64 + p] = y;
    }
}
DI void l0_level_d(Frame& F) {
    if (F.gtid < 1024) {
        const int e = (int)(F.gtid & 127), h = (int)((F.gtid >> 7) & 3), b = (int)(F.gtid >> 9);
        const float lg = ret_log_gamma(h), g64 = expf(lg * 64.0f);
        float S[128];
#pragma unroll
        for (int d = 0; d < 128; ++d) S[d] = 0.f;
#pragma unroll 1
        for (int c = 0; c < L / 64; ++c) {
#pragma unroll 1
            for (int l = 0; l < 64; ++l) { const size_t tok = (size_t)b * L + c * 64 + l; const u32x4* q = (const u32x4*)(P0B + tok * N0 + h * 128); float a = 0.f;
#pragma unroll
                for (int d8 = 0; d8 < 16; ++d8) { const u32x4 w = q[d8];
#pragma unroll
                    for (int j = 0; j < 4; ++j) { a += __uint_as_float(w[j] << 16) * S[d8 * 8 + 2 * j]; a += __uint_as_float(w[j] & 0xffff0000u) * S[d8 * 8 + 2 * j + 1]; } }
                YRS[tok * 1024 + h * 128 + e] += a * expf(lg * (float)(l + 1)); }
#pragma unroll
            for (int d = 0; d < 128; ++d) S[d] *= g64;
#pragma unroll 1
            for (int l = 0; l < 64; ++l) { const size_t tok = (size_t)b * L + c * 64 + l; const u32x4* k = (const u32x4*)(P0B + tok * N0 + 512 + h * 128);
                const float vv = bf2f(P0B[tok * N0 + 1024 + h * 128 + e]) * expf(lg * (float)(63 - l));
#pragma unroll
                for (int d8 = 0; d8 < 16; ++d8) { const u32x4 w = k[d8];
#pragma unroll
                    for (int j = 0; j < 4; ++j) { S[d8 * 8 + 2 * j] += __uint_as_float(w[j] << 16) * vv; S[d8 * 8 + 2 * j + 1] += __uint_as_float(w[j] & 0xffff0000u) * vv; } } }
        }
    } else if (F.gtid < 2048) {
        const int id = (int)(F.gtid - 1024), p = id & 63, h = (id >> 6) & 7, b = id >> 9, g = h >> 2;
        float S[128];
#pragma unroll
        for (int n = 0; n < 128; ++n) S[n] = 0.f;
#pragma unroll 1
        for (int c = 0; c < L / 64; ++c) {
            const size_t tok0 = (size_t)b * L + c * 64; const float lalast = WSP(float, WS_LAC)[(tok0 + 63) * 8 + h];
#pragma unroll 1
            for (int l = 0; l < 64; ++l) { const size_t tok = tok0 + l; const u32x4* cc = (const u32x4*)(XBC + tok * 1024 + 768 + g * 128); float a = 0.f;
#pragma unroll
                for (int d8 = 0; d8 < 16; ++d8) { const u32x4 w = cc[d8];
#pragma unroll
                    for (int j = 0; j < 4; ++j) { a += __uint_as_float(w[j] << 16) * S[d8 * 8 + 2 * j]; a += __uint_as_float(w[j] & 0xffff0000u) * S[d8 * 8 + 2 * j + 1]; } }
                YRS[tok * 1024 + 512 + h * 64 + p] += a * expf(WSP(float, WS_LAC)[tok * 8 + h]); }
            const float cd = expf(lalast);
#pragma unroll
            for (int n = 0; n < 128; ++n) S[n] *= cd;
#pragma unroll 1
            for (int l = 0; l < 64; ++l) { const size_t tok = tok0 + l; const u32x4* bb = (const u32x4*)(XBC + tok * 1024 + 512 + g * 128);
                const float vv = bf2f(XBC[tok * 1024 + h * 64 + p]) * WSP(float, WS_DT)[tok * 8 + h] * expf(lalast - WSP(float, WS_LAC)[tok * 8 + h]);
#pragma unroll
                for (int d8 = 0; d8 < 16; ++d8) { const u32x4 w = bb[d8];
#pragma unroll
                    for (int j = 0; j < 4; ++j) { S[d8 * 8 + 2 * j] += __uint_as_float(w[j] << 16) * vv; S[d8 * 8 + 2 * j + 1] += __uint_as_float(w[j] & 0xffff0000u) * vv; } } }
        }
    }
}
DI void l0_level_e(Frame& F) {
    bf16_t* mix = WSP(bf16_t, WS_MIX);
    for (long idx = F.gtid; idx < (long)T * 4; idx += F.gthreads) {
        const int h = (int)(idx & 3); const size_t tok = (size_t)(idx >> 2); const float* y = YRS + tok * 1024 + h * 128; float ss = 0.f;
        for (int e = 0; e < 128; ++e) ss += y[e] * y[e];
        const float r = 1.0f / sqrtf(ss * (1.0f / 128.0f) + EPS);
        for (int e = 0; e < 128; ++e) mix[tok * 1024 + h * 128 + e] = f2bf(silu_f(bf2f(P0B[tok * N0 + 1536 + h * 128 + e])) * y[e] * r);
    }
    for (long idx = F.gtid; idx < (long)T * 2; idx += F.gthreads) {
        const int g = (int)(idx & 1); const size_t tok = (size_t)(idx >> 1); float ss = 0.f;
        for (int j = 0; j < 256; ++j) { const int ch = g * 256 + j; const float y = (YRS[tok * 1024 + 512 + ch] + F.in[7][ch >> 6] * bf2f(XBC[tok * 1024 + ch])) * silu_f(bf2f(P0B[tok * N0 + 2048 + ch])); ss += y * y; }
        const float r = 1.0f / sqrtf(ss * (1.0f / 256.0f) + EPS);
        for (int j = 0; j < 256; ++j) { const int ch = g * 256 + j; const float y = (YRS[tok * 1024 + 512 + ch] + F.in[7][ch >> 6] * bf2f(XBC[tok * 1024 + ch])) * silu_f(bf2f(P0B[tok * N0 + 2048 + ch]));
            mix[tok * 1024 + 512 + ch] = f2bf(y * r * F.in[8][ch]); }
    }
}

#define P1B WSP(bf16_t, WS_PROJ)
#define QC WSP(bf16_t, WS_PROJ + (size_t)T * N1 * 2)
#define KC WSP(bf16_t, WS_TAIL)
#define VC WSP(bf16_t, WS_XN)
#define YG WSP(bf16_t, WS_XN + (size_t)T * 768 * 2)
DI void l1_conv(Frame& F, int c_lo, int c_hi) {
    const int nc = c_hi - c_lo;
    for (long idx = F.gtid; idx < (long)T * nc; idx += F.gthreads) {
        const int c = c_lo + (int)(idx % nc); const long tok = idx / nc; const int t = (int)(tok % L);
        float a = 0.f;
#pragma unroll
        for (int j = 0; j < 4; ++j) if (t - 3 + j >= 0) a += F.in[15][j * 2304 + c] * bf2f(P1B[(size_t)(tok - 3 + j) * N1 + c]);
        const bf16_t o = f2bf(silu_f(a));
        if (c < 768) QC[(size_t)tok * 768 + c] = o; else if (c < 1536) KC[(size_t)tok * 768 + c - 768] = o; else VC[(size_t)tok * 768 + c - 1536] = o;
    }
}
DI void l1_level_a(Frame& F) {
    l1_conv(F, 0, 1536);
    for (long idx = F.gtid; idx < (long)T * 12; idx += F.gthreads) {
        const int j = (int)(idx % 12); const size_t tok = (size_t)(idx / 12); const bf16_t* xr = WSP(bf16_t, WS_XN) + tok * D; float a = 0.f;
        for (int k = 0; k < D; ++k) a += bf2f(xr[k]) * F.in[13][k] * F.in[14][(size_t)k * N1SRC + 3072 + j];
        a *= pg8::row_rs(WSP(float, WS_SSQ), (int)tok);
        WSP(float, WS_BG)[tok * 16 + j] = j < 6 ? sigmoid_f(a) : -expf(F.in[16][j - 6]) * softplus_f(a + F.in[17][j - 6]);
    }
}
DI void l1_s5_scan(Frame& F) {
    for (int wi = F.gwave; wi < 32; wi += F.gwaves) {
        const int g = wi & 15, b = wi >> 4, n = F.lane;
        const f32x2 lam = WSP(f32x2, WS_S5C)[g * 64 + n];
        f32x2 bb[16], cc[16]; float dsk[16];
#pragma unroll
        for (int c = 0; c < 16; ++c) { bb[c] = WSP(f32x2, WS_S5C + 16 * 64 * 8)[(g * 64 + n) * 16 + c]; cc[c] = (f32x2){F.in[24][(g * 16 + c) * 64 + n], F.in[25][(g * 16 + c) * 64 + n]}; dsk[c] = F.in[26][g * 16 + c]; }
        float hre = 0.f, him = 0.f;
#pragma unroll 1
        for (int t = 0; t < L; ++t) { const size_t tok = (size_t)b * L + t; const bf16_t* up = P1B + tok * N1 + 3072 + g * 16;
            float u[16]; float bre = 0.f, bim = 0.f;
#pragma unroll
            for (int c = 0; c < 16; ++c) { u[c] = bf2f(up[c]); bre += u[c] * bb[c][0]; bim += u[c] * bb[c][1]; }
            const float nre = lam[0] * hre - lam[1] * him + bre, nim = lam[0] * him + lam[1] * hre + bim; hre = nre; him = nim;
            float mine = 0.f;
#pragma unroll
            for (int c = 0; c < 16; ++c) { const float y = wave_sum(cc[c][0] * hre - cc[c][1] * him) + dsk[c] * u[c]; mine = (n == c) ? y : mine; }
            if (n < 16) YG[tok * 256 + g * 16 + n] = f2bf(gelu_tanh_f(mine));
        }
    }
}
DI void l1_level_b(Frame& F) {
    for (long idx = F.gtid; idx < (long)T * 12; idx += F.gthreads) {
        const int h = (int)(idx % 6), which = (int)((idx / 6) & 1); const size_t tok = (size_t)(idx / 12); bf16_t* p = (which ? KC : QC) + tok * 768 + h * 128; float ss = 0.f;
        for (int d = 0; d < 128; ++d) { const float x = bf2f(p[d]); ss += x * x; }
        const float r = (1.0f / sqrtf(ss + EPS)) * (which ? 1.0f : 0.08838834764831845f);
        for (int d = 0; d < 128; ++d) p[d] = f2bf(bf2f(p[d]) * r);
    }
    for (long idx = F.gtid; idx < (long)NCHT * 6; idx += F.gthreads) {
        const int h = (int)(idx % 6); const long ch = idx / 6; float run = 0.f;
        for (int l = 0; l < 64; ++l) { const size_t tok = (size_t)ch * 64 + l; run += WSP(float, WS_BG)[tok * 16 + 6 + h]; WSP(float, WS_GC)[tok * 8 + h] = run; }
    }
}
DI void l1_s5_glu(Frame& F) {
    for (long idx = F.gtid; idx < (long)T * 256; idx += F.gthreads) {
        const int c = (int)(idx & 255); const size_t tok = (size_t)(idx >> 8); const bf16_t* y = YG + tok * 256; float z = F.in[28][c];
        for (int j = 0; j < 256; ++j) z += bf2f(y[j]) * F.in[27][j * 256 + c];
        WSP(bf16_t, WS_MIX)[tok * 1024 + 768 + c] = f2bf(bf2f(y[c]) * sigmoid_f(z));
    }
}
DI void l1_level_c(Frame& F) {
    for (long idx = F.gtid; idx < (long)NCHT * 6 * 4096; idx += F.gthreads) {
        const int s = (int)(idx & 63), l = (int)((idx >> 6) & 63); const long r2 = idx >> 12; const int h = (int)(r2 % 6); const long ch = r2 / 6;
        const size_t tl = (size_t)ch * 64 + l, ts = (size_t)ch * 64 + s; float att = 0.f, low = 0.f;
        if (s <= l) { const bf16_t* q = QC + tl * 768 + h * 128; const bf16_t* kl = KC + tl * 768 + h * 128; const bf16_t* ks = KC + ts * 768 + h * 128; float qk = 0.f, kk = 0.f;
            for (int d = 0; d < 128; ++d) { const float kv = bf2f(ks[d]); qk += bf2f(q[d]) * kv; kk += bf2f(kl[d]) * kv; }
            const float dec = expf(WSP(float, WS_GC)[tl * 8 + h] - WSP(float, WS_GC)[ts * 8 + h]);
            att = qk * dec; if (s < l) low = WSP(float, WS_BG)[tl * 16 + h] * kk * dec; }
        P1B[tl * N1 + 1536 + h * 128 + s] = f2bf(att); P1B[tl * N1 + 1536 + h * 128 + 64 + s] = f2bf(low);
    }
}
DI void l1_level_d(Frame& F) {
    LAS float* x = (LAS float*)F.lds + F.tid;
    for (long idx = F.gtid; idx < (long)NCHT * 6 * 256; idx += F.gthreads) {
        const int col = (int)(idx & 255); const long r2 = idx >> 8; const int h = (int)(r2 % 6); const long ch = r2 / 6;
#pragma unroll 1
        for (int l = 0; l < 64; ++l) { const size_t tok = (size_t)ch * 64 + l; const float beta = WSP(float, WS_BG)[tok * 16 + h];
            float r = col < 128 ? bf2f(VC[tok * 768 + h * 128 + col]) * beta : bf2f(KC[tok * 768 + h * 128 + col - 128]) * beta * expf(WSP(float, WS_GC)[tok * 8 + h]);
            const bf16_t* low = P1B + tok * N1 + 1536 + h * 128 + 64;
            for (int s = 0; s < l; ++s) r -= bf2f(low[s]) * x[s * 512];
            x[l * 512] = r; }
#pragma unroll 1
        for (int l = 0; l < 64; ++l) { const size_t tok = (size_t)ch * 64 + l; P1B[tok * N1 + (col < 128 ? h * 128 + col : 768 + h * 128 + col - 128)] = f2bf(x[l * 512]); }
    }
}
DI void l1_level_e(Frame& F) {
    if (F.gtid < 1536) {
        const int e = (int)(F.gtid & 127); const int bh = (int)(F.gtid >> 7), h = bh % 6, b = bh / 6;
        LAS float* vn = (LAS float*)F.lds + F.tid;
        float S[128];
#pragma unroll
        for (int d = 0; d < 128; ++d) S[d] = 0.f;
#pragma unroll 1
        for (int c = 0; c < L / 64; ++c) {
            const size_t tok0 = (size_t)b * L + c * 64; const float gl = WSP(float, WS_GC)[(tok0 + 63) * 8 + h];
#pragma unroll 1
            for (int l = 0; l < 64; ++l) { const size_t tok = tok0 + l; const u32x4* w = (const u32x4*)(P1B + tok * N1 + 768 + h * 128); float a = bf2f(P1B[tok * N1 + h * 128 + e]);
#pragma unroll
                for (int d8 = 0; d8 < 16; ++d8) { const u32x4 ww = w[d8];
#pragma unroll
                    for (int j = 0; j < 4; ++j) { a -= __uint_as_float(ww[j] << 16) * S[d8 * 8 + 2 * j]; a -= __uint_as_float(ww[j] & 0xffff0000u) * S[d8 * 8 + 2 * j + 1]; } }
                vn[l * 512] = a; }
#pragma unroll 1
            for (int l = 0; l < 64; ++l) { const size_t tok = tok0 + l; const u32x4* q = (const u32x4*)(QC + tok * 768 + h * 128); float a = 0.f;
#pragma unroll
                for (int d8 = 0; d8 < 16; ++d8) { const u32x4 ww = q[d8];
#pragma unroll
                    for (int j = 0; j < 4; ++j) { a += __uint_as_float(ww[j] << 16) * S[d8 * 8 + 2 * j]; a += __uint_as_float(ww[j] & 0xffff0000u) * S[d8 * 8 + 2 * j + 1]; } }
                a *= expf(WSP(float, WS_GC)[tok * 8 + h]);
                const bf16_t* att = P1B + tok * N1 + 1536 + h * 128;
                for (int s = 0; s <= l; ++s) a += bf2f(att[s]) * vn[s * 512];
                P1B[tok * N1 + h * 128 + e] = f2bf(a); }
            const float cd = expf(gl);
#pragma unroll
            for (int d = 0; d < 128; ++d) S[d] *= cd;
#pragma unroll 1
            for (int l = 0; l < 64; ++l) { const size_t tok = tok0 + l; const u32x4* k = (const u32x4*)(KC + tok * 768 + h * 128); const float vv = vn[l * 512] * expf(gl - WSP(float, WS_GC)[tok * 8 + h]);
#pragma unroll
                for (int d8 = 0; d8 < 16; ++d8) { const u32x4 ww = k[d8];
#pragma unroll
                    for (int j = 0; j < 4; ++j) { S[d8 * 8 + 2 * j] += __uint_as_float(ww[j] << 16) * vv; S[d8 * 8 + 2 * j + 1] += __uint_as_float(ww[j] & 0xffff0000u) * vv; } } }
        }
    }
}
DI void l1_level_f(Frame& F) {
    for (long idx = F.gtid; idx < (long)T * 6; idx += F.gthreads) {
        const int h = (int)(idx % 6); const size_t tok = (size_t)(idx / 6); const bf16_t* o = P1B + tok * N1 + h * 128; float ss = 0.f;
        for (int e = 0; e < 128; ++e) { const float v = bf2f(o[e]); ss += v * v; }
        const float r = 1.0f / sqrtf(ss * (1.0f / 128.0f) + EPS);
        for (int e = 0; e < 128; ++e) WSP(bf16_t, WS_MIX)[tok * 1024 + h * 128 + e] = f2bf(bf2f(o[e]) * r * F.in[18][e] * silu_f(bf2f(P1B[tok * N1 + 2304 + h * 128 + e])));
    }
}
DI void final_norm(Frame& F) {
    for (int m = F.gwave; m < T; m += F.gwaves) {
        f32x4* xr = (f32x4*)(F.out + (size_t)m * D) + F.lane; const f32x4* wr = (const f32x4*)F.in[33] + F.lane;
        f32x4 v[4]; float s = 0.f;
#pragma unroll
        for (int j = 0; j < 4; ++j) { v[j] = xr[64 * j]; s += (v[j][0] * v[j][0] + v[j][1] * v[j][1]) + (v[j][2] * v[j][2] + v[j][3] * v[j][3]); }
        const float rs = 1.0f / sqrtf(wave_sum(s) * (1.0f / D) + EPS);
#pragma unroll
        for (int j = 0; j < 4; ++j) xr[64 * j] = v[j] * rs * wr[64 * j];
    }
}

constexpr int NPHASES = 21;
DI void run_phase(Frame& F, int ph) {
    using namespace pg8;
    StaticOrder S;
    switch (ph) {
    case 0: p0_prologue(F); break;
    case 1: { Gemm g{WSP(bf16_t, WS_XN), WSP(bf16_t, WS_W_IN0), T, N0, D}; S.init(T, N0, F.G, (int)blockIdx.x); EpiProj E{WSP(bf16_t, WS_PROJ), N0, nullptr, 0}; gemm_phase(F.lds, g, S, E); } break;
    case 2: l0_level_a(F); break;
    case 3: l0_level_b(F); break;
    case 4: l0_level_c(F); break;
    case 5: l0_level_d(F); break;
    case 6: l0_level_e(F); break;
    case 7: { Gemm g{WSP(bf16_t, WS_MIX), WSP(bf16_t, WS_W_OUT0), T, D, D}; S.init(T, D, F.G, (int)blockIdx.x); EpiResid E{F.in[0], F.out, WSP(bf16_t, WS_XN), WSP(float, WS_SSQ)}; gemm_phase(F.lds, g, S, E); } break;
    case 8: { Gemm g{WSP(bf16_t, WS_XN), WSP(bf16_t, WS_W_UP0), T, DFF, D}; S.init(T, DFF, F.G, (int)blockIdx.x); EpiProj E{WSP(bf16_t, WS_PROJ), DFF, WSP(float, WS_SSQ), 1}; gemm_phase(F.lds, g, S, E); } break;
    case 9: { Gemm g{WSP(bf16_t, WS_PROJ), WSP(bf16_t, WS_W_DN0), T, D, DFF}; S.init(T, D, F.G, (int)blockIdx.x); EpiResid E{F.out, F.out, WSP(bf16_t, WS_XN), WSP(float, WS_SSQ)}; gemm_phase(F.lds, g, S, E); } break;
    case 10: { Gemm g{WSP(bf16_t, WS_XN), WSP(bf16_t, WS_W_IN1), T, N1, D}; S.init(T, N1, F.G, (int)blockIdx.x); EpiProj E{WSP(bf16_t, WS_PROJ), N1, WSP(float, WS_SSQ), 0}; gemm_phase(F.lds, g, S, E); } break;
    case 11: l1_level_a(F); break;
    case 12: l1_conv(F, 1536, 2304); l1_s5_scan(F); l1_level_b(F); break;
    case 13: l1_level_c(F); l1_s5_glu(F); break;
    case 14: l1_level_d(F); break;
    case 15: l1_level_e(F); break;
    case 16: l1_level_f(F); break;
    case 17: { Gemm g{WSP(bf16_t, WS_MIX), WSP(bf16_t, WS_W_OUT1), T, D, D}; S.init(T, D, F.G, (int)blockIdx.x); EpiResid E{F.out, F.out, WSP(bf16_t, WS_XN), WSP(float, WS_SSQ)}; gemm_phase(F.lds, g, S, E); } break;
    case 18: { Gemm g{WSP(bf16_t, WS_XN), WSP(bf16_t, WS_W_UP1), T, DFF, D}; S.init(T, DFF, F.G, (int)blockIdx.x); EpiProj E{WSP(bf16_t, WS_PROJ), DFF, WSP(float, WS_SSQ), 1}; gemm_phase(F.lds, g, S, E); } break;
    case 19: { Gemm g{WSP(bf16_t, WS_PROJ), WSP(bf16_t, WS_W_DN1), T, D, DFF}; S.init(T, D, F.G, (int)blockIdx.x); EpiResid E{F.out, F.out, WSP(bf16_t, WS_XN), WSP(float, WS_SSQ)}; gemm_phase(F.lds, g, S, E); } break;
    case 20: final_norm(F); break;
    default: break;
    }
}

template <int PH> __global__ void __launch_bounds__(NTHREADS, 2) phase_kernel(Params p) {
#ifndef CPU_EMU
    extern __shared__ __attribute__((aligned(16))) unsigned char lds_raw[];
    LAS unsigned char* lds = (LAS unsigned char*)lds_raw;
#else
    unsigned char* lds = emu::cur->blk->lds;
#endif
    Frame F;
    F.lds = lds; F.tid = threadIdx.x; F.lane = F.tid & 63; F.wave = __builtin_amdgcn_readfirstlane(F.tid >> 6); F.G = gridDim.x;
    F.gtid = (long)blockIdx.x * NTHREADS + F.tid; F.gthreads = (long)F.G * NTHREADS; F.gwave = (int)blockIdx.x * (NTHREADS / 64) + F.wave; F.gwaves = F.G * (NTHREADS / 64);
    F.in = p.in; F.out = p.out; F.ws = p.ws;
    run_phase(F, PH);
}
#if N_LAUNCH_MODE == 1 || defined(CPU_EMU)
__global__ void __launch_bounds__(NTHREADS, 2) fwd_kernel(Params p) {
#ifndef CPU_EMU
    extern __shared__ __attribute__((aligned(16))) unsigned char lds_raw[];
    LAS unsigned char* lds = (LAS unsigned char*)lds_raw;
#else
    unsigned char* lds = emu::cur->blk->lds;
#endif
    Frame F;
    F.lds = lds; F.tid = threadIdx.x; F.lane = F.tid & 63; F.wave = __builtin_amdgcn_readfirstlane(F.tid >> 6); F.G = gridDim.x;
    F.gtid = (long)blockIdx.x * NTHREADS + F.tid; F.gthreads = (long)F.G * NTHREADS; F.gwave = (int)blockIdx.x * (NTHREADS / 64) + F.wave; F.gwaves = F.G * (NTHREADS / 64);
    F.in = p.in; F.out = p.out; F.ws = p.ws;
    for (int ph = p.ph_lo; ph < p.ph_hi; ++ph) {
        run_phase(F, ph);
        if (ph + 1 < p.ph_hi) cg::this_grid().sync();
    }
}
#endif
template <int PH> static void launch_phases(Params& p, int grid, hipStream_t stream) {
    if constexpr (PH < NPHASES) {
#ifndef CPU_EMU
        static bool attr = false;
        if (!attr) { (void)hipFuncSetAttribute((const void*)phase_kernel<PH>, hipFuncAttributeMaxDynamicSharedMemorySize, LDS_BYTES); attr = true; }
        hipLaunchKernelGGL(phase_kernel<PH>, dim3(grid), dim3(NTHREADS), LDS_BYTES, stream, p);
#endif
        launch_phases<PH + 1>(p, grid, stream);
    }
}

#ifndef CPU_EMU
#if N_LAUNCH_MODE == 1
#define MAIN_KERNEL fwd_kernel
#else
#define MAIN_KERNEL phase_kernel<1>
#endif
extern "C" void kernel_launch(void* const* d_in, const int* in_sizes, int n_in, void* d_out, int out_size, void* d_ws, size_t ws_size, hipStream_t stream) {
    static int grid = 0;
    if (grid == 0) {
        if (n_in != 34 || out_size != T * D || ws_size < WS_END) { fprintf(stderr, "kernel_launch: unexpected shapes (n_in %d out %d ws %zu need %zu)\n", n_in, out_size, ws_size, (size_t)WS_END); grid = -1; return; }
        int dev = 0, cus = 0, per_cu = 0;
        (void)hipGetDevice(&dev); (void)hipDeviceGetAttribute(&cus, hipDeviceAttributeMultiprocessorCount, dev);
        if (hipFuncSetAttribute((const void*)MAIN_KERNEL, hipFuncAttributeMaxDynamicSharedMemorySize, LDS_BYTES) != hipSuccess) { fprintf(stderr, "kernel_launch: hipFuncSetAttribute failed\n"); grid = -1; return; }
        if (hipOccupancyMaxActiveBlocksPerMultiprocessor(&per_cu, (const void*)MAIN_KERNEL, NTHREADS, LDS_BYTES) != hipSuccess || per_cu < 1) { fprintf(stderr, "kernel_launch: occupancy query says %d\n", per_cu); per_cu = 1; }
        (void)hipGetLastError();
        grid = cus;
    }
    if (grid < 0) return;
    Params p{};
    for (int i = 0; i < 34; ++i) p.in[i] = (const float*)d_in[i];
    p.out = (float*)d_out; p.ws = (unsigned char*)d_ws;
#if N_LAUNCH_MODE == 1
    p.ph_lo = 0; p.ph_hi = NPHASES;
    void* args[] = {&p};
    hipError_t e = hipLaunchCooperativeKernel((const void*)fwd_kernel, dim3(grid), dim3(NTHREADS), args, LDS_BYTES, stream);
    if (e != hipSuccess) fprintf(stderr, "kernel_launch: cooperative launch failed: %s (grid %d)\n", hipGetErrorString(e), grid);
#else
    launch_phases<0>(p, grid, stream);
#endif
}
#endif
```

```cpp
#ifndef CPU_EMU
#include <hip/hip_runtime.h>
#include <hip/hip_cooperative_groups.h>
#include <cstdio>
#define LAS __attribute__((address_space(3)))
#define GLDS16(g, l) __builtin_amdgcn_global_load_lds((const unsigned*)(g), (LAS unsigned*)(l), 16, 0, 0)
#define WAIT_V(n) asm volatile("s_waitcnt vmcnt(" #n ")" ::: "memory")
#define WAIT_L(n) asm volatile("s_waitcnt lgkmcnt(" #n ")" ::: "memory")
#else
#define LAS
#define GLDS16(g, l) memcpy((unsigned char*)(l) + 16 * (threadIdx.x & 63), (const void*)(g), 16)
#define WAIT_V(n) emu::wave_barrier()
#define WAIT_L(n) emu::wave_barrier()
#endif
namespace cg = cooperative_groups;
#define DI __device__ __forceinline__
#ifndef CPU_EMU
#define OPAQUE_V(x) asm volatile("" : "+v"(x))
#else
#define OPAQUE_V(x) ((void)0)
#endif

#ifndef SEQ_LEN
#define SEQ_LEN 16384
#endif
#ifndef PROBE_REPEAT
#define PROBE_REPEAT -1
#endif
#ifndef N_LAUNCH_MODE
#define N_LAUNCH_MODE 1
#endif

typedef unsigned short bf16_t;
typedef short bf16x8 __attribute__((ext_vector_type(8)));
typedef float f32x4 __attribute__((ext_vector_type(4)));
typedef float f32x2 __attribute__((ext_vector_type(2)));
typedef unsigned u32x4 __attribute__((ext_vector_type(4)));
typedef unsigned u32x2 __attribute__((ext_vector_type(2)));

constexpr int BATCH = 2, L = SEQ_LEN, T = BATCH * L, NCHT = T / 64  , D = 1024, DFF = 4096;
constexpr int N0 = 3584;
constexpr int N0SRC = 3592;
constexpr int N1 = 3328;
constexpr int N1SRC = 3340;
constexpr int N1G = 3584;
constexpr float EPS = 1e-6f;
constexpr int NTHREADS = 512, LDS_BYTES = 147456;

constexpr size_t MiB = 1u << 20;
constexpr size_t WS_CTL = 0;
constexpr size_t WS_W_IN0 = 1 * MiB, WS_W_OUT0 = WS_W_IN0 + (size_t)N0 * D * 2, WS_W_UP0 = WS_W_OUT0 + (size_t)D * D * 2, WS_W_DN0 = WS_W_UP0 + (size_t)DFF * D * 2,
                 WS_W_IN1 = WS_W_DN0 + (size_t)D * DFF * 2, WS_W_OUT1 = WS_W_IN1 + (size_t)N1G * D * 2, WS_W_UP1 = WS_W_OUT1 + (size_t)D * D * 2, WS_W_DN1 = WS_W_UP1 + (size_t)DFF * D * 2,
                 WS_W_END = WS_W_DN1 + (size_t)D * DFF * 2;
static_assert(WS_W_END <= 52 * MiB, "weights");
constexpr size_t WS_YG = WS_W_IN0;
constexpr size_t WS_ROPE = 52 * MiB;
constexpr size_t WS_S5C = WS_ROPE + (size_t)L * 64 * 8;
constexpr size_t WS_WDT = WS_S5C + 16 * 64 * 8 + 16 * 64 * 16 * 8;
constexpr size_t WS_SMALL = ((WS_WDT + 1024 * 8 * 4 + 4095) / 4096) * 4096;
constexpr size_t WS_DT = WS_SMALL;
constexpr size_t WS_BG = WS_DT + (size_t)T * 8 * 4;
constexpr size_t WS_LAC = WS_BG + (size_t)T * 16 * 4;
constexpr size_t WS_GC = WS_LAC + (size_t)T * 8 * 4;
constexpr size_t WS_SSQ = WS_GC + (size_t)T * 8 * 4;
constexpr size_t WS_XN = ((WS_SSQ + (size_t)T * 16 * 4 + MiB - 1) / MiB) * MiB;
constexpr size_t WS_MIX = WS_XN + (size_t)T * D * 2;
constexpr size_t WS_PROJ = WS_MIX + (size_t)T * D * 2;
constexpr size_t WS_TAIL = WS_PROJ + (size_t)T * DFF * 2;
constexpr size_t WS_S5_H = WS_TAIL + (size_t)T * 1536;
constexpr size_t WS_S5_MG = WS_S5_H + 16 * 256 * 256 * 2;
constexpr size_t WS_S5_WG = WS_S5_MG + 16 * 256 * 384 * 2;
constexpr size_t WS_END = WS_S5_WG + 256 * 256 * 2;
constexpr size_t WS_S5_HL = WS_XN + (size_t)T * 3840;
constexpr size_t WS_S5_HP = WS_ROPE;
static_assert(SEQ_LEN != 16384 || WS_END <= 512 * MiB, "workspace");

struct Params { const float* in[34]; float* out; unsigned char* ws; int ph_lo, ph_hi; };

DI float bf2f(bf16_t b) { return __uint_as_float(((unsigned)b) << 16); }
DI bf16_t f2bf(float f) { unsigned u = __float_as_uint(f); return (bf16_t)((u + 0x7fffu + ((u >> 16) & 1u)) >> 16); }
DI unsigned pk2(float lo, float hi) { return (unsigned)f2bf(lo) | ((unsigned)f2bf(hi) << 16); }
#ifndef CPU_EMU
typedef __bf16 bf16v2_t __attribute__((ext_vector_type(2)));
DI unsigned cvt_pk_bf16(float lo, float hi) { bf16v2_t v; v[0] = (__bf16)lo; v[1] = (__bf16)hi; return __builtin_bit_cast(unsigned, v); }
#else
DI unsigned cvt_pk_bf16(float lo, float hi) { return pk2(lo, hi); }
#endif
DI float silu_f(float x) { return x * __builtin_amdgcn_rcpf(1.0f + __expf(-x)); }
DI float silu_fast(float x) { return x * __builtin_amdgcn_rcpf(1.0f + __expf(-x)); }
DI float sigmoid_f(float x) { return __builtin_amdgcn_rcpf(1.0f + __expf(-x)); }
DI float softplus_f(float x) { return x > 20.0f ? x : log1pf(expf(x)); }
DI float gelu_tanh_f(float x) { const float u = 0.7978845608028654f * (x + 0.044715f * x * x * x); return x * (1.0f - __builtin_amdgcn_rcpf(1.0f + __expf(2.0f * u))); }
DI float wave_sum(float v) {
#pragma unroll
    for (int o = 1; o < 64; o <<= 1) v += __shfl_xor(v, o);
    return v;
}
DI bf16x8 ldsfrag(const LAS bf16_t* base, int row, int col, int pitch) { return *(const LAS bf16x8*)(base + row * pitch + col); }
DI bf16x8 pack8(const f32x4 a, const f32x4 b) { u32x4 w; w.x = cvt_pk_bf16(a[0], a[1]); w.y = cvt_pk_bf16(a[2], a[3]); w.z = cvt_pk_bf16(b[0], b[1]); w.w = cvt_pk_bf16(b[2], b[3]); return __builtin_bit_cast(bf16x8, w); }
DI float sel4(const f32x4 v, int i) { return i == 0 ? v[0] : i == 1 ? v[1] : i == 2 ? v[2] : v[3]; }
DI void sincos_rev(double rev, double& s, double& c) {
    const double fr = rev - rint(rev); const double q = rint(fr * 4.0); const double r = (fr - q * 0.25) * 6.283185307179586476925; const double r2 = r * r;
    const double sr = r * (1.0 + r2 * (-1.0 / 6.0 + r2 * (1.0 / 120.0 + r2 * (-1.0 / 5040.0 + r2 * (1.0 / 362880.0 + r2 * (-1.0 / 39916800.0 + r2 * (1.0 / 6227020800.0)))))));
    const double cr = 1.0 + r2 * (-0.5 + r2 * (1.0 / 24.0 + r2 * (-1.0 / 720.0 + r2 * (1.0 / 40320.0 + r2 * (-1.0 / 3628800.0 + r2 * (1.0 / 479001600.0 + r2 * (-1.0 / 87178291200.0)))))));
    const int qi = ((int)q) & 3;
    s = qi == 0 ? sr : qi == 1 ? cr : qi == 2 ? -sr : -cr;
    c = qi == 0 ? cr : qi == 1 ? -sr : qi == 2 ? -cr : sr;
}

namespace pg8 {
constexpr int BM = 256, BK = 64, HALF = 128, HTB = HALF * BK * 2, STAGE_BYTES = 8 * HTB, NXCD = 8, WGM = 8;
DI int lds_byte(int r, int c) { const int st = (r >> 4) * 2 + (c >> 5), rr = r & 15, cc = c & 31, ob = rr * 64 + cc * 2; return st * 1024 + (ob ^ (((ob >> 9) & 1) << 5)); }
DI void stage_rc(int b, int& R, int& C) { const int st = b / 1024, sb = b % 1024, swz = sb ^ (((sb >> 9) & 1) << 5); R = (st >> 1) * 16 + swz / 64; C = (st & 1) * 32 + (swz % 64) / 2; }
DI int perm32(int rho) { const int n = rho >> 4, i = rho & 15; return 8 * (i >> 2) + 4 * n + (i & 3); }
struct Unit { int pm, pn, g, ord; };
struct Gemm { const bf16_t* Bt; int K; size_t bgroup; };
struct StaticOrder {
    int nM, nN, nwg, G, c;
    DI void init(int M, int N, int G_, int c_) { nM = M / BM; nN = N / BM; nwg = nM * nN; G = G_; c = c_; }
    DI bool next(int i, Unit& u) const {
        const long Lx = (long)i * G + c; if (Lx >= nwg) return false;
        int wgid = (int)Lx; { const int q = nwg / NXCD, r = nwg % NXCD, xcd = wgid % NXCD, off = wgid / NXCD; wgid = (xcd < r ? xcd * (q + 1) : r * (q + 1) + (xcd - r) * q) + off; }
        const int nig = WGM * nN, gid = wgid / nig, fm = gid * WGM, gsz = (nM - fm) < WGM ? (nM - fm) : WGM;
        u.pm = fm + ((wgid % nig) % gsz); u.pn = (wgid % nig) / gsz; u.g = 0; return true;
    }
};
struct BatchOrder {
    int nM, nwg, G, c;
    DI void init(int nM_, int ngroups, int G_, int c_) { nM = nM_; nwg = nM_ * ngroups; G = G_; c = c_; }
    DI bool next(int i, Unit& u) const { if (c < 0) return false; const long Lx = (long)i * G + c; if (Lx >= nwg) return false; u.g = (int)Lx / nM; u.pm = (int)Lx % nM; u.pn = 0; return true; }
};
struct AStd {
    const char* A; int K; unsigned v[2];
    DI void lane_init(int tid) {
#pragma unroll
        for (int i = 0; i < 2; ++i) { int R, C; stage_rc(tid * 16 + i * 8192, R, C); v[i] = (unsigned)(R * K + C) * 2u; } }
    DI const char* tile(const Unit& u, int half, int t) const { return A + ((size_t)u.pm * 256 + half * 128) * K * 2 + (size_t)t * 128; }
    DI const unsigned* voff(int) const { return v; }
};
struct AS5 {
    const char* U; const char* HP; unsigned vu[2], vh[2];
    static constexpr size_t ROWP = (size_t)16 * N1 * 2;
    DI void lane_init(int tid) {
#pragma unroll
        for (int i = 0; i < 2; ++i) { int R, C; stage_rc(tid * 16 + i * 8192, R, C); vu[i] = (unsigned)((size_t)R * ROWP + (size_t)(C >> 4) * N1 * 2 + (C & 15) * 2); vh[i] = (unsigned)(R * 256 + C * 2); } }
    DI const char* tile(const Unit& u, int half, int t) const {
        return t < 4 ? U + (size_t)u.g * 32 + ((size_t)u.pm * 256 + half * 128) * ROWP + (size_t)t * 4 * N1 * 2 : HP + (((size_t)u.g * (T / 16) + (size_t)u.pm * 256 + half * 128) * 128 + (size_t)(t - 4) * 64) * 2; }
    DI const unsigned* voff(int t) const { return t < 4 ? vu : vh; }
};
#ifndef CPU_EMU
DI void store16_wt(void* p, const u32x4 v) { asm volatile("global_store_dwordx4 %0, %1, off sc1\n\ts_nop 1" :: "v"(p), "v"(v) : "memory"); }
DI void store4_wt(void* p, const float v) { asm volatile("global_store_dword %0, %1, off sc1\n\ts_nop 1" :: "v"(p), "v"(v) : "memory"); }
DI void store4u_wt(void* p, const unsigned v) { asm volatile("global_store_dword %0, %1, off sc1\n\ts_nop 1" :: "v"(p), "v"(v) : "memory"); }
DI void store8_wt(void* p, const u32x2 v) { asm volatile("global_store_dwordx2 %0, %1, off sc1\n\ts_nop 1" :: "v"(p), "v"(v) : "memory"); }
#else
DI void store16_wt(void* p, const u32x4 v) { *(u32x4*)p = v; }
DI void store4_wt(void* p, const float v) { *(float*)p = v; }
DI void store4u_wt(void* p, const unsigned v) { *(unsigned*)p = v; }
DI void store8_wt(void* p, const u32x2 v) { *(u32x2*)p = v; }
#endif
DI float row_rs(const float* ssq, int row) {
    const f32x4* p = (const f32x4*)(ssq + (size_t)row * 16); const f32x4 a = p[0], b = p[1], c = p[2], d = p[3];
    const float s = ((a[0] + a[1]) + (a[2] + a[3])) + ((b[0] + b[1]) + (b[2] + b[3])) + ((c[0] + c[1]) + (c[2] + c[3])) + ((d[0] + d[1]) + (d[2] + d[3]));
    return 1.0f / sqrtf(s * (1.0f / 1024.0f) + EPS);
}
template <class Ord> DI void prep_rs(LAS float* rsl, const Ord& S, const float* ssq) {
    const int par = (int)threadIdx.x >> 8, r = (int)threadIdx.x & 255; f32x4 v[4][4]; bool ok[4];
#pragma unroll
    for (int j = 0; j < 4; ++j) { Unit u; ok[j] = S.next(par + 2 * j, u);
        if (ok[j]) { const f32x4* p = (const f32x4*)(ssq + (size_t)(u.pm * BM + r) * 16); v[j][0] = p[0]; v[j][1] = p[1]; v[j][2] = p[2]; v[j][3] = p[3]; } }
#pragma unroll
    for (int j = 0; j < 4; ++j) if (ok[j]) { const f32x4 a = v[j][0], b = v[j][1], c = v[j][2], d = v[j][3];
        const float s = ((a[0] + a[1]) + (a[2] + a[3])) + ((b[0] + b[1]) + (b[2] + b[3])) + ((c[0] + c[1]) + (c[2] + c[3])) + ((d[0] + d[1]) + (d[2] + d[3]));
        rsl[(par + 2 * j) * 256 + r] = __builtin_amdgcn_rsqf(s * (1.0f / 1024.0f) + EPS); }
    __syncthreads();
}
struct EpiProj {
    static constexpr bool PERM = true;
    bf16_t* O; int ldc; const float* ssq; int act; int ba_pn; float* bg; const float* alog; const float* dtb; const LAS float* rsl;
    DI void operator()(const f32x4 (&acc)[2][2][4][2], const Unit& u, int wr, int wc, int fr, int fq, bool lastu) const {
        const int row0 = u.pm * BM + wr * 64 + fr, col0 = u.pn * BM + wc * 32 + 8 * fq;
        if (u.pn == ba_pn) {
            if (wc == 0 && fq < 2) {
#pragma unroll
                for (int ai = 0; ai < 2; ++ai)
#pragma unroll
                    for (int m = 0; m < 4; ++m) { const int row = row0 + ai * HALF + m * 16; const float rs = rsl[u.ord * 256 + wr * 64 + fr + ai * HALF + m * 16]; float* o = bg + (size_t)row * 16;
#pragma unroll
                        for (int n = 0; n < 2; ++n) *(f32x4*)(o + 8 * fq + 4 * n) = acc[ai][0][m][n] * rs; }
            }
            return;
        }
#pragma unroll
        for (int ai = 0; ai < 2; ++ai)
#pragma unroll
            for (int m = 0; m < 4; ++m) { const int row = row0 + ai * HALF + m * 16; const float rs = ssq ? rsl[u.ord * 256 + wr * 64 + fr + ai * HALF + m * 16] : 1.0f; bf16_t* rowp = O + (size_t)row * ldc + col0;
#pragma unroll
                for (int bj = 0; bj < 2; ++bj) { f32x4 v0 = acc[ai][bj][m][0] * rs, v1 = acc[ai][bj][m][1] * rs;
                    if (act == 1) {
#pragma unroll
                        for (int j = 0; j < 4; ++j) { const float a0 = v0[j] > 0.f ? v0[j] : 0.f, a1 = v1[j] > 0.f ? v1[j] : 0.f; v0[j] = a0 * a0; v1[j] = a1 * a1; } }
                    u32x4 w; w.x = cvt_pk_bf16(v0[0], v0[1]); w.y = cvt_pk_bf16(v0[2], v0[3]); w.z = cvt_pk_bf16(v1[0], v1[1]); w.w = cvt_pk_bf16(v1[2], v1[3]);
                    if (lastu) store16_wt(rowp + bj * HALF, w); else *(u32x4*)(rowp + bj * HALF) = w; } }
    }
};
template <bool BASE_F32> struct EpiResid {
    static constexpr bool PERM = true;
    const float* basef; bf16_t* xr; float* ssq;
    DI void fin(const f32x4 (&acc)[2][2][4][2], const Unit& u, int wc, int fq, int row, size_t off, int ai, int m, const f32x4 (&b)[2][2], bool wt) const { float ss = 0.f;
#pragma unroll
        for (int bj = 0; bj < 2; ++bj) { const f32x4 o0 = b[bj][0] + acc[ai][bj][m][0], o1 = b[bj][1] + acc[ai][bj][m][1];
            ss += ((o0[0] * o0[0] + o0[1] * o0[1]) + (o0[2] * o0[2] + o0[3] * o0[3])) + ((o1[0] * o1[0] + o1[1] * o1[1]) + (o1[2] * o1[2] + o1[3] * o1[3]));
            u32x4 w; w.x = cvt_pk_bf16(o0[0], o0[1]); w.y = cvt_pk_bf16(o0[2], o0[3]); w.z = cvt_pk_bf16(o1[0], o1[1]); w.w = cvt_pk_bf16(o1[2], o1[3]); if (wt) store16_wt(xr + off + bj * HALF, w); else *(u32x4*)(xr + off + bj * HALF) = w; }
        ss += __shfl_xor(ss, 16); ss += __shfl_xor(ss, 32);
        if (fq == 0) ssq[(size_t)row * 16 + u.pn * 4 + wc] = ss; }
    DI void operator()(const f32x4 (&acc)[2][2][4][2], const Unit& u, int wr, int wc, int fr, int fq, bool lastu) const {
        const int row0 = u.pm * BM + wr * 64 + fr, col0 = u.pn * BM + wc * 32 + 8 * fq;
        if constexpr (BASE_F32) {
            f32x4 b0[2][2], b1[2][2], b2[2][2];
            auto ldb = [&](int k, f32x4 (&b)[2][2]) { const int ai = k >> 2, m = k & 3;
#pragma unroll
                for (int bj = 0; bj < 2; ++bj) { const size_t o2 = (size_t)(row0 + ai * HALF + m * 16) * D + col0 + bj * HALF; b[bj][0] = *(const f32x4*)(basef + o2); b[bj][1] = *(const f32x4*)(basef + o2 + 4); } };
            auto fnb = [&](int k, const f32x4 (&b)[2][2]) { const int ai = k >> 2, m = k & 3, row = row0 + ai * HALF + m * 16; fin(acc, u, wc, fq, row, (size_t)row * D + col0, ai, m, b, lastu); };
            ldb(0, b0); ldb(1, b1); ldb(2, b2); fnb(0, b0); ldb(3, b0); fnb(1, b1); ldb(4, b1); fnb(2, b2); ldb(5, b2); fnb(3, b0); ldb(6, b0); fnb(4, b1); ldb(7, b1); fnb(5, b2); fnb(6, b0); fnb(7, b1);
        } else {
            u32x4 b0[2][2], b1[2][2], b2[2][2];
            auto ldb = [&](int k, u32x4 (&b)[2][2]) { const int ai = k >> 1, mh = k & 1;
#pragma unroll
                for (int mm = 0; mm < 2; ++mm)
#pragma unroll
                    for (int bj = 0; bj < 2; ++bj) b[mm][bj] = *(const u32x4*)(xr + (size_t)(row0 + ai * HALF + (2 * mh + mm) * 16) * D + col0 + bj * HALF); };
            auto fnb = [&](int k, const u32x4 (&bq)[2][2]) { const int ai = k >> 1, mh = k & 1;
#pragma unroll
                for (int mm = 0; mm < 2; ++mm) { const int m = 2 * mh + mm, row = row0 + ai * HALF + m * 16; f32x4 b[2][2];
#pragma unroll
                    for (int bj = 0; bj < 2; ++bj) { const u32x4 q = bq[mm][bj];
                        b[bj][0] = (f32x4){__uint_as_float(q.x << 16), __uint_as_float(q.x & 0xffff0000u), __uint_as_float(q.y << 16), __uint_as_float(q.y & 0xffff0000u)};
                        b[bj][1] = (f32x4){__uint_as_float(q.z << 16), __uint_as_float(q.z & 0xffff0000u), __uint_as_float(q.w << 16), __uint_as_float(q.w & 0xffff0000u)}; }
                    fin(acc, u, wc, fq, row, (size_t)row * D + col0, ai, m, b, lastu); } };
            ldb(0, b0); ldb(1, b1); ldb(2, b2); fnb(0, b0); ldb(3, b0); fnb(1, b1); fnb(2, b2); fnb(3, b0);
        }
    }
};
struct EpiS5State {
    static constexpr bool PERM = true;
    bf16_t* HL;
    DI void operator()(const f32x4 (&acc)[2][2][4][2], const Unit& u, int wr, int wc, int fr, int fq, bool lastu) const {
        const int row0 = u.pm * BM + wr * 64 + fr, col0 = wc * 32 + 8 * fq;
#pragma unroll
        for (int ai = 0; ai < 2; ++ai)
#pragma unroll
            for (int m = 0; m < 4; ++m) { const int row = row0 + ai * HALF + m * 16; const f32x4 v0 = acc[ai][0][m][0], v1 = acc[ai][0][m][1];
                u32x4 w; w.x = cvt_pk_bf16(v0[0], v0[1]); w.y = cvt_pk_bf16(v0[2], v0[3]); w.z = cvt_pk_bf16(v1[0], v1[1]); w.w = cvt_pk_bf16(v1[2], v1[3]);
                *(u32x4*)(HL + ((size_t)u.g * (T / 16) + row) * 128 + col0) = w; }
    }
};
struct EpiS5Y {
    static constexpr bool PERM = false;
    bf16_t* YGp;
    DI void operator()(const f32x4 (&acc)[2][2][4][2], const Unit& u, int wr, int wc, int fr, int fq, bool lastu) const {
        const int row0 = u.pm * BM + wr * 64 + fr, col0 = wc * 32 + 4 * fq;
#pragma unroll
        for (int ai = 0; ai < 2; ++ai)
#pragma unroll
            for (int m = 0; m < 4; ++m) { const int row = row0 + ai * HALF + m * 16;
#pragma unroll
                for (int bj = 0; bj < 2; ++bj)
#pragma unroll
                    for (int n = 0; n < 2; ++n) { const int col = col0 + bj * HALF + n * 16, l = col >> 4, c = col & 15; const f32x4 v = acc[ai][bj][m][n];
                        u32x2 w; w.x = cvt_pk_bf16(gelu_tanh_f(v[0]), gelu_tanh_f(v[1])); w.y = cvt_pk_bf16(gelu_tanh_f(v[2]), gelu_tanh_f(v[3]));
                        *(u32x2*)(YGp + ((size_t)row * 16 + l) * 256 + u.g * 16 + c) = w; } }
    }
};
DI float fast_sigmoid(float x) { return __builtin_amdgcn_rcpf(1.0f + __expf(-x)); }
struct EpiS5Glu {
    static constexpr bool PERM = true;
    const float* bglu; bf16_t* mix;
    DI void operator()(const f32x4 (&acc)[2][2][4][2], const Unit& u, int wr, int wc, int fr, int fq, bool lastu) const {
        const int row0 = u.pm * BM + wr * 64 + fr, col0 = wc * 32 + 8 * fq;
        f32x4 bv[2][2];
#pragma unroll
        for (int bj = 0; bj < 2; ++bj)
#pragma unroll
            for (int n = 0; n < 2; ++n) bv[bj][n] = *(const f32x4*)(bglu + col0 + bj * HALF + 4 * n);
#pragma unroll
        for (int ai = 0; ai < 2; ++ai)
#pragma unroll
            for (int m = 0; m < 4; ++m) { bf16_t* rowp = mix + (size_t)(row0 + ai * HALF + m * 16) * 1024 + 768 + col0;
#pragma unroll
                for (int bj = 0; bj < 2; ++bj) { const f32x4 v0 = acc[ai][bj][m][0] + bv[bj][0], v1 = acc[ai][bj][m][1] + bv[bj][1];
                    u32x4 w; w.x = cvt_pk_bf16(v0[0], v0[1]); w.y = cvt_pk_bf16(v0[2], v0[3]); w.z = cvt_pk_bf16(v1[0], v1[1]); w.w = cvt_pk_bf16(v1[2], v1[3]);
                    *(u32x4*)(rowp + bj * HALF) = w; } }
    }
};

template <bool ALIGN_EPI = true, bool SP2 = true, class Epi, class AP, class Ord>
DI void gemm_phase(LAS unsigned char* lds, const Gemm g, AP A, const Ord& S, const Epi& E) {
    const int tid = threadIdx.x, wid = __builtin_amdgcn_readfirstlane(tid >> 6), lane = tid & 63, wr = wid >> 2, wc = wid & 3, fr = lane & 15, fq = lane >> 4;
    const int K = g.K, nt = K / BK;
    unsigned voffB[2];
    A.lane_init(tid);
#pragma unroll
    for (int i = 0; i < 2; ++i) { int R, C; stage_rc(tid * 16 + i * 8192, R, C); const int Rb = Epi::PERM ? ((R & ~31) + perm32(R & 31)) : R; voffB[i] = (unsigned)(Rb * K + C) * 2u; }
    const size_t kstep = (size_t)(BK * 2);
    const size_t hstep = (size_t)HALF * K * 2;
    const size_t tstep = 2 * hstep;
    const unsigned ldsw = (unsigned)wid * 1024u;
    const int aoff = lds_byte(wr * 64 + fr, fq * 8), boff = lds_byte(wc * 32 + fr, fq * 8);
#define PG8_SA(b, h) (((b) * 2 + (h)) * HTB)
#define PG8_SB(b, h) ((4 + (b) * 2 + (h)) * HTB)
#define PG8_STAGE(bufoff, gbase, voff) do { _Pragma("unroll") for (int _i = 0; _i < 2; ++_i) \
        GLDS16((const char*)(gbase) + (voff)[_i], lds + (bufoff) + ldsw + _i * 8192); } while (0)
#define PG8_LDA(dst, b, h) do { _Pragma("unroll") for (int m = 0; m < 4; ++m) _Pragma("unroll") for (int k = 0; k < 2; ++k) dst[m][k] = *(const LAS bf16x8*)(lds + PG8_SA(b, h) + aoff + m * 2048 + k * 1024); } while (0)
#define PG8_LDB(dst, b, h) do { _Pragma("unroll") for (int n = 0; n < 2; ++n) _Pragma("unroll") for (int k = 0; k < 2; ++k) dst[n][k] = *(const LAS bf16x8*)(lds + PG8_SB(b, h) + boff + n * 2048 + k * 1024); } while (0)
#define PG8_MMA(ai, bj, At, Bt) do { __builtin_amdgcn_s_setprio(1); _Pragma("unroll") for (int m = 0; m < 4; ++m) _Pragma("unroll") for (int n = 0; n < 2; ++n) _Pragma("unroll") for (int k = 0; k < 2; ++k) \
        acc[ai][bj][m][n] = __builtin_amdgcn_mfma_f32_16x16x32_bf16(Bt[n][k], At[m][k], acc[ai][bj][m][n], 0, 0, 0); __builtin_amdgcn_s_setprio(0); } while (0)
#define PG8_BAR __builtin_amdgcn_s_barrier()
#define PG8_SCHED __builtin_amdgcn_sched_barrier(0)
    Unit cur, nxt; int ui = 0;
    if (!S.next(0, cur)) return;
    cur.ord = 0;
    f32x4 acc[2][2][4][2];
#pragma unroll
    for (int a = 0; a < 2; ++a)
#pragma unroll
        for (int b = 0; b < 2; ++b)
#pragma unroll
            for (int m = 0; m < 4; ++m)
#pragma unroll
                for (int n = 0; n < 2; ++n) acc[a][b][m][n] = (f32x4){0.f, 0.f, 0.f, 0.f};
    bf16x8 At[4][2], B0[2][2], B1[2][2];
    const char* cB = (const char*)g.Bt + (size_t)cur.g * g.bgroup + (size_t)cur.pn * tstep;
    if constexpr (SP2) {
        PG8_STAGE(PG8_SB(0, 0), cB, voffB); PG8_STAGE(PG8_SB(0, 1), cB + hstep, voffB); PG8_STAGE(PG8_SA(0, 0), A.tile(cur, 0, 0), A.voff(0)); PG8_STAGE(PG8_SA(0, 1), A.tile(cur, 1, 0), A.voff(0));
        if (wr == 1) PG8_BAR;
        WAIT_V(2); PG8_BAR;
        PG8_STAGE(PG8_SB(1, 0), cB + kstep, voffB); PG8_STAGE(PG8_SA(1, 0), A.tile(cur, 0, 1), A.voff(1)); PG8_STAGE(PG8_SB(1, 1), cB + hstep + kstep, voffB);
        WAIT_V(6); PG8_BAR;
    } else {
        PG8_STAGE(PG8_SB(0, 0), cB, voffB); PG8_STAGE(PG8_SA(0, 0), A.tile(cur, 0, 0), A.voff(0)); PG8_STAGE(PG8_SB(0, 1), cB + hstep, voffB); PG8_STAGE(PG8_SA(0, 1), A.tile(cur, 1, 0), A.voff(0));
        if (wr == 1) PG8_BAR;
        WAIT_V(4); PG8_BAR;
        PG8_STAGE(PG8_SB(1, 0), cB + kstep, voffB); PG8_STAGE(PG8_SA(1, 0), A.tile(cur, 0, 1), A.voff(1)); PG8_STAGE(PG8_SB(1, 1), cB + hstep + kstep, voffB);
        WAIT_V(6); PG8_BAR;
    }
    for (;;) {
        const bool has_next = S.next(ui + 1, nxt); nxt.ord = ui + 1;
        const Unit un = has_next ? nxt : cur;
        const char* nB = (const char*)g.Bt + (size_t)un.g * g.bgroup + (size_t)un.pn * tstep;
#pragma unroll 1
        for (int t = 0; t < nt; t += 2) {
            const bool last = (t == nt - 2);
            const Unit u2 = last ? un : cur; const int t2 = last ? 0 : t + 2;
            const char* b2 = last ? nB : cB + (size_t)(t + 2) * kstep; const char* b3 = b2 + kstep;
            if constexpr (SP2) {
            PG8_LDB(B0, 0, 0); PG8_LDB(B1, 0, 1); PG8_SCHED; PG8_LDA(At, 0, 0); PG8_STAGE(PG8_SA(1, 1), A.tile(cur, 1, t + 1), A.voff(t + 1));
            WAIT_V(8); WAIT_L(0); PG8_BAR; PG8_MMA(0, 0, At, B0); PG8_MMA(0, 1, At, B1); PG8_BAR; PG8_SCHED;
            PG8_LDA(At, 0, 1); PG8_STAGE(PG8_SB(0, 0), b2, voffB); PG8_STAGE(PG8_SB(0, 1), b2 + hstep, voffB); PG8_STAGE(PG8_SA(0, 0), A.tile(u2, 0, t2), A.voff(t2));
            WAIT_V(8); WAIT_L(0); PG8_BAR; PG8_MMA(1, 0, At, B0); PG8_MMA(1, 1, At, B1); PG8_BAR; PG8_SCHED;
            PG8_LDB(B0, 1, 0); PG8_LDB(B1, 1, 1); PG8_SCHED; PG8_LDA(At, 1, 0); PG8_STAGE(PG8_SA(0, 1), A.tile(u2, 1, t2), A.voff(t2));
            WAIT_V(8); WAIT_L(0); PG8_BAR; PG8_MMA(0, 0, At, B0); PG8_MMA(0, 1, At, B1); PG8_BAR; PG8_SCHED;
            PG8_LDA(At, 1, 1); PG8_STAGE(PG8_SB(1, 0), b3, voffB); PG8_STAGE(PG8_SB(1, 1), b3 + hstep, voffB); PG8_STAGE(PG8_SA(1, 0), A.tile(u2, 0, t2 + 1), A.voff(t2 + 1));
            WAIT_V(8); WAIT_L(0); PG8_BAR; PG8_MMA(1, 0, At, B0); PG8_MMA(1, 1, At, B1); PG8_BAR; PG8_SCHED;
            } else {
            PG8_LDB(B0, 0, 0); PG8_SCHED; PG8_LDA(At, 0, 0); PG8_STAGE(PG8_SA(1, 1), A.tile(cur, 1, t + 1), A.voff(t + 1));
            WAIT_L(8); PG8_BAR; WAIT_L(0); PG8_MMA(0, 0, At, B0); PG8_BAR; PG8_SCHED;
            PG8_LDB(B1, 0, 1); PG8_STAGE(PG8_SB(0, 0), b2, voffB);
            PG8_BAR; WAIT_L(0); PG8_MMA(0, 1, At, B1); PG8_BAR;
            PG8_LDA(At, 0, 1); PG8_STAGE(PG8_SA(0, 0), A.tile(u2, 0, t2), A.voff(t2));
            PG8_BAR; WAIT_L(0); PG8_MMA(1, 0, At, B0); PG8_BAR; PG8_SCHED;
            PG8_STAGE(PG8_SB(0, 1), b2 + hstep, voffB);
            WAIT_V(6); PG8_BAR; PG8_MMA(1, 1, At, B1); PG8_BAR;
            PG8_LDB(B0, 1, 0); PG8_SCHED; PG8_LDA(At, 1, 0); PG8_STAGE(PG8_SA(0, 1), A.tile(u2, 1, t2), A.voff(t2));
            WAIT_L(8); PG8_BAR; WAIT_L(0); PG8_MMA(0, 0, At, B0); PG8_BAR; PG8_SCHED;
            PG8_LDB(B1, 1, 1); PG8_STAGE(PG8_SB(1, 0), b3, voffB);
            PG8_BAR; WAIT_L(0); PG8_MMA(0, 1, At, B1); PG8_BAR;
            PG8_LDA(At, 1, 1); PG8_STAGE(PG8_SA(1, 0), A.tile(u2, 0, t2 + 1), A.voff(t2 + 1));
            PG8_BAR; WAIT_L(0); PG8_MMA(1, 0, At, B0); PG8_BAR; PG8_SCHED;
            PG8_STAGE(PG8_SB(1, 1), b3 + hstep, voffB);
            WAIT_V(6); PG8_BAR; PG8_MMA(1, 1, At, B1); PG8_BAR;
            }
        }
        if constexpr (ALIGN_EPI) { if (wr == 0) PG8_BAR; }
        E(acc, cur, wr, wc, fr, fq, !has_next);
        if (!has_next) break;
#pragma unroll
        for (int a = 0; a < 2; ++a)
#pragma unroll
            for (int b = 0; b < 2; ++b)
#pragma unroll
                for (int m = 0; m < 4; ++m)
#pragma unroll
                    for (int n = 0; n < 2; ++n) acc[a][b][m][n] = (f32x4){0.f, 0.f, 0.f, 0.f};
        cur = nxt; cB = nB; ++ui;
        if constexpr (ALIGN_EPI) { if (wr == 1) PG8_BAR; }
    }
    WAIT_V(0);
    if constexpr (!ALIGN_EPI) { if (wr == 0) PG8_BAR; }
    PG8_BAR;
#undef PG8_SA
#undef PG8_SB
#undef PG8_STAGE
#undef PG8_LDA
#undef PG8_LDB
#undef PG8_MMA
#undef PG8_BAR
#undef PG8_SCHED
}
}
using pg8::store16_wt; using pg8::store4_wt; using pg8::store4u_wt; using pg8::store8_wt;

#ifndef CPU_EMU
#define KAS __attribute__((address_space(4)))
#else
#define KAS
#endif
struct InPtrs { const KAS Params* q; DI const float* operator[](int k) const { return q->in[k]; } };
struct Frame {
    LAS unsigned char* lds; int tid, lane, wave, G; long gtid, gthreads; int gwave, gwaves;
    InPtrs in; float* out; unsigned char* ws;
};
#define WSP(type, off) ((type*)(F.ws + (off)))
#define XRES ((bf16_t*)F.out)

DI void p0_transpose_item(const float* W, int K, int Nsrc, int N, const float* scale, int split, int gap, bf16_t* WT, LAS float* scr, int item, int lane) {
    const int nblk = N / 32, kb = item / nblk, nb = item % nblk, k0 = 64 * kb, n0 = 32 * nb, s0 = n0 < split ? n0 : (n0 < N1 ? n0 + gap : split);
    float wv[32];
#pragma unroll
    for (int i = 0; i < 32; ++i) { const int kk = 2 * i + (lane >> 5); wv[i] = W[(size_t)(k0 + kk) * Nsrc + s0 + (lane & 31)] * (scale ? scale[k0 + kk] : 1.0f); }
#pragma unroll
    for (int i = 0; i < 32; ++i) { const int kk = 2 * i + (lane >> 5); scr[kk * 33 + (lane & 31)] = wv[i]; }
    WAIT_L(0); asm volatile("" ::: "memory");
    const int c = lane & 7;
#pragma unroll
    for (int j = 0; j < 4; ++j) { const int n = (lane >> 3) + 8 * j; const LAS float* s = scr + (8 * c) * 33 + n;
        u32x4 o; o.x = pk2(s[0 * 33], s[1 * 33]); o.y = pk2(s[2 * 33], s[3 * 33]); o.z = pk2(s[4 * 33], s[5 * 33]); o.w = pk2(s[6 * 33], s[7 * 33]);
        *(u32x4*)(WT + (size_t)(n0 + n) * K + k0 + 8 * c) = o; }
    WAIT_L(0); asm volatile("" ::: "memory");
}
DI void s5_lam(const InPtrs in, int g, int n, double& lre, double& lim, double& fre, double& fim) {
    const double are = in[19][g * 64 + n], aim = in[20][g * 64 + n], step = exp((double)in[21][g]);
    const double mag = exp(are * step); double sn, cs; sincos_rev(aim * step * 0.15915494309189533577, sn, cs); lre = mag * cs; lim = mag * sn;
    const double nre = lre - 1.0, nim = lim, den = are * are + aim * aim; fre = (nre * are + nim * aim) / den; fim = (nim * are - nre * aim) / den;
}
DI void p0_prologue(Frame& F) {
    LAS float* scr = (LAS float*)(F.lds + F.wave * 16384);
    constexpr int I_IN0 = (D / 64) * (N0 / 32), I_SQ = (D / 64) * (D / 32), I_UP = (D / 64) * (DFF / 32), I_DN = (DFF / 64) * (D / 32), I_IN1 = (D / 64) * (N1G / 32), I_WG = (256 / 64) * (256 / 32);
    constexpr int NITEMS = I_IN0 + I_IN1 + 2 * (I_SQ + I_UP + I_DN) + I_WG;
    for (int it = F.gwave; it < NITEMS; it += F.gwaves) {
        int r = it;
        if (r < I_IN0) { p0_transpose_item(F.in[2], D, N0SRC, N0, F.in[1], 1 << 30, 0, WSP(bf16_t, WS_W_IN0), scr, r, F.lane); continue; } r -= I_IN0;
        if (r < I_SQ) { p0_transpose_item(F.in[9], D, D, D, nullptr, 1 << 30, 0, WSP(bf16_t, WS_W_OUT0), scr, r, F.lane); continue; } r -= I_SQ;
        if (r < I_UP) { p0_transpose_item(F.in[11], D, DFF, DFF, F.in[10], 1 << 30, 0, WSP(bf16_t, WS_W_UP0), scr, r, F.lane); continue; } r -= I_UP;
        if (r < I_DN) { p0_transpose_item(F.in[12], DFF, D, D, nullptr, 1 << 30, 0, WSP(bf16_t, WS_W_DN0), scr, r, F.lane); continue; } r -= I_DN;
        if (r < I_IN1) { p0_transpose_item(F.in[14], D, N1SRC, N1G, F.in[13], 3072, 12, WSP(bf16_t, WS_W_IN1), scr, r, F.lane); continue; } r -= I_IN1;
        if (r < I_WG) { p0_transpose_item(F.in[27], 256, 256, 256, nullptr, 1 << 30, 0, WSP(bf16_t, WS_S5_WG), scr, r, F.lane); continue; } r -= I_WG;
        if (r < I_SQ) { p0_transpose_item(F.in[29], D, D, D, nullptr, 1 << 30, 0, WSP(bf16_t, WS_W_OUT1), scr, r, F.lane); continue; } r -= I_SQ;
        if (r < I_UP) { p0_transpose_item(F.in[31], D, DFF, DFF, F.in[30], 1 << 30, 0, WSP(bf16_t, WS_W_UP1), scr, r, F.lane); continue; } r -= I_UP;
        p0_transpose_item(F.in[32], DFF, D, D, nullptr, 1 << 30, 0, WSP(bf16_t, WS_W_DN1), scr, r, F.lane);
    }
    __syncthreads();
    LAS float* wdt = (LAS float*)F.lds;
    for (int i = F.tid; i < 1024 * 8; i += NTHREADS) { const int k = i >> 3, c = i & 7; wdt[i] = F.in[1][k] * F.in[2][(size_t)k * N0SRC + N0 + c]; }
    __syncthreads();
    f32x4 vnx[4];
    if (F.gwave < T) { const f32x4* xr = (const f32x4*)(F.in[0] + (size_t)F.gwave * D) + F.lane;
#pragma unroll
        for (int j = 0; j < 4; ++j) vnx[j] = xr[64 * j]; }
    for (int m = F.gwave; m < T; m += F.gwaves) {
        f32x4 v[4]; float s = 0.f;
#pragma unroll
        for (int j = 0; j < 4; ++j) { v[j] = vnx[j]; s += (v[j][0] * v[j][0] + v[j][1] * v[j][1]) + (v[j][2] * v[j][2] + v[j][3] * v[j][3]); }
        if (m + F.gwaves < T) { const f32x4* xr = (const f32x4*)(F.in[0] + (size_t)(m + F.gwaves) * D) + F.lane;
#pragma unroll
            for (int j = 0; j < 4; ++j) vnx[j] = xr[64 * j]; }
        const float rs = __builtin_amdgcn_rsqf(wave_sum(s) * (1.0f / D) + EPS);
        float dacc[8];
#pragma unroll
        for (int c = 0; c < 8; ++c) dacc[c] = 0.f;
        unsigned long long* o8 = (unsigned long long*)(WSP(bf16_t, WS_XN) + (size_t)m * D) + F.lane;
#pragma unroll
        for (int j = 0; j < 4; ++j) {
            v[j] = v[j] * rs;
            o8[64 * j] = (unsigned long long)pk2(v[j][0], v[j][1]) | ((unsigned long long)pk2(v[j][2], v[j][3]) << 32);
#pragma unroll
            for (int e = 0; e < 4; ++e) { const LAS f32x4* wp = (const LAS f32x4*)(wdt + (size_t)(4 * F.lane + 256 * j + e) * 8); const f32x4 w0 = wp[0], w1 = wp[1];
#pragma unroll
                for (int c = 0; c < 4; ++c) { dacc[c] += v[j][e] * w0[c]; dacc[4 + c] += v[j][e] * w1[c]; } }
        }
#pragma unroll
        for (int c = 0; c < 8; ++c) dacc[c] = wave_sum(dacc[c]);
        float mine = 0.f;
#pragma unroll
        for (int c = 0; c < 8; ++c) mine = (F.lane == c) ? dacc[c] : mine;
        if (F.lane < 8) WSP(float, WS_DT)[(size_t)m * 8 + F.lane] = softplus_f(mine + F.in[5][F.lane]);
    }
    for (long i = F.gtid; i < (long)L * 64; i += F.gthreads) {
        const int fi = (int)(i & 63), t = (int)(i >> 6);
        double inv = 1.0;
        if (fi & 1) inv *= 0.86596432336006535; if (fi & 2) inv *= 0.74989420933245582; if (fi & 4) inv *= 0.56234132519034908;
        if (fi & 8) inv *= 0.31622776601683794; if (fi & 16) inv *= 0.1; if (fi & 32) inv *= 0.01;
        double s, c; sincos_rev((double)t * inv * 0.15915494309189533577, s, c);
        WSP(f32x2, WS_ROPE)[i] = (f32x2){(float)c, (float)s};
    }
    bf16_t* MG = WSP(bf16_t, WS_S5_MG); bf16_t* HM = WSP(bf16_t, WS_S5_H);
    __syncthreads();
    LAS double* PWR = (LAS double*)F.lds; LAS double* PWI = PWR + 17 * 64; LAS double* FRE = PWI + 17 * 64; LAS double* FIM = FRE + 64;
    LAS float* BBR = (LAS float*)(FIM + 64); LAS float* BBI = BBR + 1024; LAS float* CRE = BBI + 1024; LAS float* CIM = CRE + 1024;
    auto build = [&](int g) { __syncthreads(); if (F.tid < 64) { double lre, lim, fre, fim; s5_lam(F.in, g, F.tid, lre, lim, fre, fim); FRE[F.tid] = fre; FIM[F.tid] = fim; double pre = 1.0, pim = 0.0;
            for (int k = 0; k <= 16; ++k) { PWR[k * 64 + F.tid] = pre; PWI[k * 64 + F.tid] = pim; const double t = pre * lre - pim * lim; pim = pre * lim + pim * lre; pre = t; }
            for (int c2 = 0; c2 < 16; ++c2) { const double bre = F.in[22][(g * 64 + F.tid) * 16 + c2], bim = F.in[23][(g * 64 + F.tid) * 16 + c2]; BBR[F.tid * 16 + c2] = (float)(fre * bre - fim * bim); BBI[F.tid * 16 + c2] = (float)(fre * bim + fim * bre); } }
        for (int k = F.tid; k < 1024; k += NTHREADS) { CRE[k] = F.in[24][g * 1024 + k]; CIM[k] = F.in[25][g * 1024 + k]; }
        __syncthreads(); };
    for (long base = (long)blockIdx.x * NTHREADS; base < 65536; base += F.gthreads) { const long i = base + F.tid; const int g = (int)(base >> 12); build(g);
        const int cp = (int)(i & 15), c = (int)((i >> 4) & 15), dl = (int)((i >> 8) & 15); double acc = 0.0;
        for (int n = 0; n < 64; ++n) { const double pre = PWR[dl * 64 + n], pim = PWI[dl * 64 + n], bbre = BBR[n * 16 + cp], bbim = BBI[n * 16 + cp];
            const double qre = pre * bbre - pim * bbim, qim = pre * bbim + pim * bbre; acc += (double)CRE[c * 64 + n] * qre - (double)CIM[c * 64 + n] * qim; }
        if (dl == 0 && c == cp) acc += (double)F.in[26][g * 16 + c];
        const bf16_t v = f2bf((float)acc);
        for (int l = dl; l < 16; ++l) MG[((size_t)g * 256 + l * 16 + c) * 384 + (l - dl) * 16 + cp] = v;
    }
    for (long i = F.gtid; i < 16L * 256 * 256; i += F.gthreads) { const int col = (int)(i & 255), row = (int)((i >> 8) & 255), g = (int)(i >> 16);
        if ((col >> 4) > (row >> 4)) MG[((size_t)g * 256 + row) * 384 + col] = 0;
        if (row >= 128) HM[((size_t)g * 256 + row) * 256 + col] = 0; }
    for (long base = (long)blockIdx.x * NTHREADS; base < 16L * 256 * 64; base += F.gthreads) { const long i = base + F.tid; const int g = (int)(base >> 14); build(g);
        const int n = (int)(i & 63), row = (int)((i >> 6) & 255), l = row >> 4, c = row & 15; const double pre = PWR[(l + 1) * 64 + n], pim = PWI[(l + 1) * 64 + n];
        const double cre = F.in[24][(g * 16 + c) * 64 + n], cim = F.in[25][(g * 16 + c) * 64 + n];
        MG[((size_t)g * 256 + row) * 384 + 256 + n] = f2bf((float)(cre * pre - cim * pim)); MG[((size_t)g * 256 + row) * 384 + 320 + n] = f2bf((float)(-(cre * pim + cim * pre))); }
    for (long base = (long)blockIdx.x * NTHREADS; base < 16L * 64 * 256; base += F.gthreads) { const long i = base + F.tid; const int g = (int)(base >> 14); build(g);
        const int col = (int)(i & 255), n = (int)((i >> 8) & 63), sidx = col >> 4, cp = col & 15; const double pre = PWR[(15 - sidx) * 64 + n], pim = PWI[(15 - sidx) * 64 + n], fre = FRE[n], fim = FIM[n];
        const double bre = F.in[22][(g * 64 + n) * 16 + cp], bim = F.in[23][(g * 64 + n) * 16 + cp]; const double bbre = fre * bre - fim * bim, bbim = fre * bim + fim * bre;
        HM[((size_t)g * 256 + n) * 256 + col] = f2bf((float)(pre * bbre - pim * bbim)); HM[((size_t)g * 256 + 64 + n) * 256 + col] = f2bf((float)(pre * bbim + pim * bbre)); }
}

#define P0B WSP(bf16_t, WS_PROJ)
#define XBC WSP(bf16_t, WS_XN)
#define SCB WSP(float, WS_TAIL)
#define CBB WSP(float, WS_PROJ + (size_t)T * N0 * 2)
#define YRS (F.out)
DI float ret_log_gamma(int h) { return logf(1.0f - exp2f(-5.0f - (float)h)); }

DI void l0_level_a(Frame& F) {
    const f32x2* rope = WSP(f32x2, WS_ROPE);
    for (long idx = F.gtid; idx < (long)T * 512; idx += F.gthreads) {
        const int i = (int)(idx & 63), h = (int)((idx >> 6) & 3), which = (int)((idx >> 8) & 1); const long tok = idx >> 9; const int t = (int)(tok % L);
        bf16_t* p = P0B + (size_t)tok * N0 + which * 512 + h * 128 + i;
        const float x1 = bf2f(p[0]), x2 = bf2f(p[64]); const f32x2 cs = rope[(size_t)t * 64 + i]; const float sc = which == 0 ? 0.08838834764831845f : 1.0f;
        p[0] = f2bf((x1 * cs[0] - x2 * cs[1]) * sc); p[64] = f2bf((x1 * cs[1] + x2 * cs[0]) * sc);
    }
    for (long idx = F.gtid; idx < (long)T * 1024; idx += F.gthreads) {
        const int c = (int)(idx & 1023); const long tok = idx >> 10; const int t = (int)(tok % L);
        float a = F.in[4][c];
#pragma unroll
        for (int j = 0; j < 4; ++j) if (t - 3 + j >= 0) a += F.in[3][j * 1024 + c] * bf2f(P0B[(size_t)(tok - 3 + j) * N0 + 2560 + c]);
        XBC[(size_t)tok * 1024 + c] = f2bf(silu_f(a));
    }
    for (long idx = F.gtid; idx < (long)NCHT * 8; idx += F.gthreads) {
        const int h = (int)(idx & 7); const long ch = idx >> 3; const float a = -expf(F.in[6][h]); float run = 0.f;
        for (int l = 0; l < 64; ++l) { const size_t tok = (size_t)ch * 64 + l; run += WSP(float, WS_DT)[tok * 8 + h] * a; WSP(float, WS_LAC)[tok * 8 + h] = run; }
    }
}
DI void l0_level_b(Frame& F) {
    for (long idx = F.gtid; idx < (long)NCHT * 4 * 4096; idx += F.gthreads) {
        const int s = (int)(idx & 63), l = (int)((idx >> 6) & 63), h = (int)((idx >> 12) & 3); const long ch = idx >> 14;
        float v = 0.f;
        if (s <= l) { const bf16_t* q = P0B + (size_t)(ch * 64 + l) * N0 + h * 128; const bf16_t* k = P0B + (size_t)(ch * 64 + s) * N0 + 512 + h * 128;
            for (int d = 0; d < 128; ++d) v += bf2f(q[d]) * bf2f(k[d]);
            v *= expf(ret_log_gamma(h) * (float)(l - s)); }
        SCB[idx] = v;
    }
    for (long idx = F.gtid; idx < (long)NCHT * 2 * 4096; idx += F.gthreads) {
        const int s = (int)(idx & 63), l = (int)((idx >> 6) & 63), g = (int)((idx >> 12) & 1); const long ch = idx >> 13;
        float v = 0.f;
        if (s <= l) { const bf16_t* c = XBC + (size_t)(ch * 64 + l) * 1024 + 768 + g * 128; const bf16_t* b = XBC + (size_t)(ch * 64 + s) * 1024 + 512 + g * 128;
            for (int n = 0; n < 128; ++n) v += bf2f(c[n]) * bf2f(b[n]); }
        CBB[idx] = v;
    }
}
DI void l0_level_c(Frame& F) {
    for (long idx = F.gtid; idx < (long)T * 512; idx += F.gthreads) {
        const int e = (int)(idx & 127), h = (int)((idx >> 7) & 3); const long tok = idx >> 9, ch = tok >> 6; const int l = (int)(tok & 63);
        const float* sc = SCB + ((size_t)(ch * 4 + h) * 64 + l) * 64; float y = 0.f;
        for (int s = 0; s <= l; ++s) y += sc[s] * bf2f(P0B[(size_t)(ch * 64 + s) * N0 + 1024 + h * 128 + e]);
        YRS[(size_t)tok * 1024 + h * 128 + e] = y;
    }
    for (long idx = F.gtid; idx < (long)T * 512; idx += F.gthreads) {
        const int p = (int)(idx & 63), h = (int)((idx >> 6) & 7), g = h >> 2; const long tok = idx >> 9, ch = tok >> 6; const int l = (int)(tok & 63);
        const float* cb = CBB + ((size_t)(ch * 2 + g) * 64 + l) * 64; const float lal = WSP(float, WS_LAC)[(size_t)tok * 8 + h]; float y = 0.f;
        for (int s = 0; s <= l; ++s) { const size_t ts = (size_t)ch * 64 + s;
            y += cb[s] * expf(lal - WSP(float, WS_LAC)[ts * 8 + h]) * bf2f(XBC[ts * 1024 + h * 64 + p]) * WSP(float, WS_DT)[ts * 8 + h]; }
        YRS[(size_t)tok * 1024 + 512 + h * 64 + p] = y;
    }
}
DI void l0_level_d(Frame& F) {
    if (F.gtid < 1024) {
        const int e = (int)(F.gtid & 127), h = (int)((F.gtid >> 7) & 3), b = (int)(F.gtid >> 9);
        const float lg = ret_log_gamma(h), g64 = expf(lg * 64.0f);
        float S[128];
#pragma unroll
        for (int d = 0; d < 128; ++d) S[d] = 0.f;
#pragma unroll 1
        for (int c = 0; c < L / 64; ++c) {
#pragma unroll 1
            for (int l = 0; l < 64; ++l) { const size_t tok = (size_t)b * L + c * 64 + l; const u32x4* q = (const u32x4*)(P0B + tok * N0 + h * 128); float a = 0.f;
#pragma unroll
                for (int d8 = 0; d8 < 16; ++d8) { const u32x4 w = q[d8];
#pragma unroll
                    for (int j = 0; j < 4; ++j) { a += __uint_as_float(w[j] << 16) * S[d8 * 8 + 2 * j]; a += __uint_as_float(w[j] & 0xffff0000u) * S[d8 * 8 + 2 * j + 1]; } }
                YRS[tok * 1024 + h * 128 + e] += a * expf(lg * (float)(l + 1)); }
#pragma unroll
            for (int d = 0; d < 128; ++d) S[d] *= g64;
#pragma unroll 1
            for (int l = 0; l < 64; ++l) { const size_t tok = (size_t)b * L + c * 64 + l; const u32x4* k = (const u32x4*)(P0B + tok * N0 + 512 + h * 128);
                const float vv = bf2f(P0B[tok * N0 + 1024 + h * 128 + e]) * expf(lg * (float)(63 - l));
#pragma unroll
                for (int d8 = 0; d8 < 16; ++d8) { const u32x4 w = k[d8];
#pragma unroll
                    for (int j = 0; j < 4; ++j) { S[d8 * 8 + 2 * j] += __uint_as_float(w[j] << 16) * vv; S[d8 * 8 + 2 * j + 1] += __uint_as_float(w[j] & 0xffff0000u) * vv; } } }
        }
    } else if (F.gtid < 2048) {
        const int id = (int)(F.gtid - 1024), p = id & 63, h = (id >> 6) & 7, b = id >> 9, g = h >> 2;
        float S[128];
#pragma unroll
        for (int n = 0; n < 128; ++n) S[n] = 0.f;
#pragma unroll 1
        for (int c = 0; c < L / 64; ++c) {
            const size_t tok0 = (size_t)b * L + c * 64; const float lalast = WSP(float, WS_LAC)[(tok0 + 63) * 8 + h];
#pragma unroll 1
            for (int l = 0; l < 64; ++l) { const size_t tok = tok0 + l; const u32x4* cc = (const u32x4*)(XBC + tok * 1024 + 768 + g * 128); float a = 0.f;
#pragma unroll
                for (int d8 = 0; d8 < 16; ++d8) { const u32x4 w = cc[d8];
#pragma unroll
                    for (int j = 0; j < 4; ++j) { a += __uint_as_float(w[j] << 16) * S[d8 * 8 + 2 * j]; a += __uint_as_float(w[j] & 0xffff0000u) * S[d8 * 8 + 2 * j + 1]; } }
                YRS[tok * 1024 + 512 + h * 64 + p] += a * expf(WSP(float, WS_LAC)[tok * 8 + h]); }
            const float cd = expf(lalast);
#pragma unroll
            for (int n = 0; n < 128; ++n) S[n] *= cd;
#pragma unroll 1
            for (int l = 0; l < 64; ++l) { const size_t tok = tok0 + l; const u32x4* bb = (const u32x4*)(XBC + tok * 1024 + 512 + g * 128);
                const float vv = bf2f(XBC[tok * 1024 + h * 64 + p]) * WSP(float, WS_DT)[tok * 8 + h] * expf(lalast - WSP(float, WS_LAC)[tok * 8 + h]);
#pragma unroll
                for (int d8 = 0; d8 < 16; ++d8) { const u32x4 w = bb[d8];
#pragma unroll
                    for (int j = 0; j < 4; ++j) { S[d8 * 8 + 2 * j] += __uint_as_float(w[j] << 16) * vv; S[d8 * 8 + 2 * j + 1] += __uint_as_float(w[j] & 0xffff0000u) * vv; } } }
        }
    }
}
DI void l0_level_e(Frame& F) {
    bf16_t* mix = WSP(bf16_t, WS_MIX);
    for (long idx = F.gtid; idx < (long)T * 4; idx += F.gthreads) {
        const int h = (int)(idx & 3); const size_t tok = (size_t)(idx >> 2); const float* y = YRS + tok * 1024 + h * 128; float ss = 0.f;
        for (int e = 0; e < 128; ++e) ss += y[e] * y[e];
        const float r = 1.0f / sqrtf(ss * (1.0f / 128.0f) + EPS);
        for (int e = 0; e < 128; ++e) mix[tok * 1024 + h * 128 + e] = f2bf(silu_f(bf2f(P0B[tok * N0 + 1536 + h * 128 + e])) * y[e] * r);
    }
    for (long idx = F.gtid; idx < (long)T * 2; idx += F.gthreads) {
        const int g = (int)(idx & 1); const size_t tok = (size_t)(idx >> 1); float ss = 0.f;
        for (int j = 0; j < 256; ++j) { const int ch = g * 256 + j; const float y = (YRS[tok * 1024 + 512 + ch] + F.in[7][ch >> 6] * bf2f(XBC[tok * 1024 + ch])) * silu_f(bf2f(P0B[tok * N0 + 2048 + ch])); ss += y * y; }
        const float r = 1.0f / sqrtf(ss * (1.0f / 256.0f) + EPS);
        for (int j = 0; j < 256; ++j) { const int ch = g * 256 + j; const float y = (YRS[tok * 1024 + 512 + ch] + F.in[7][ch >> 6] * bf2f(XBC[tok * 1024 + ch])) * silu_f(bf2f(P0B[tok * N0 + 2048 + ch]));
            mix[tok * 1024 + 512 + ch] = f2bf(y * r * F.in[8][ch]); }
    }
}


DI float bflo(unsigned w) { return __uint_as_float(w << 16); }
DI float bfhi(unsigned w) { return __uint_as_float(w & 0xffff0000u); }
DI float u4elem(const u32x4 v, int c) { const unsigned w = (c >> 1) == 0 ? v.x : (c >> 1) == 1 ? v.y : (c >> 1) == 2 ? v.z : v.w; return (c & 1) ? bfhi(w) : bflo(w); }
DI void conv_oct_weights(const float* w, int wpitch, const float* bias, f32x4 (&wl)[4][2], f32x4 (&bl)[2]) {
#pragma unroll
    for (int t = 0; t < 4; ++t) { wl[t][0] = *(const f32x4*)(w + t * wpitch); wl[t][1] = *(const f32x4*)(w + t * wpitch + 4); }
    bl[0] = (f32x4){0.f, 0.f, 0.f, 0.f}; bl[1] = bl[0];
    if (bias) { bl[0] = *(const f32x4*)bias; bl[1] = *(const f32x4*)(bias + 4); }
}
DI void conv_oct_apply(const u32x4 (&x)[11], const f32x4 (&wl)[4][2], const f32x4 (&bl)[2], u32x4 (&yr)[8]) {
#pragma unroll
    for (int q4 = 0; q4 < 4; ++q4) {
        const int hf = q4 & 1, r0 = 4 * (q4 >> 1);
#pragma unroll
        for (int r = r0; r < r0 + 4; ++r) { float a[4];
#pragma unroll
            for (int c = 0; c < 4; ++c) { float v = bl[hf][c];
#pragma unroll
                for (int t = 0; t < 4; ++t) { const unsigned wv = hf == 0 ? (c < 2 ? x[r + t].x : x[r + t].y) : (c < 2 ? x[r + t].z : x[r + t].w); v += wl[t][hf][c] * ((c & 1) ? bfhi(wv) : bflo(wv)); }
                a[c] = silu_fast(v); }
            if (hf == 0) { yr[r].x = pk2(a[0], a[1]); yr[r].y = pk2(a[2], a[3]); } else { yr[r].z = pk2(a[0], a[1]); yr[r].w = pk2(a[2], a[3]); } }
        __builtin_amdgcn_sched_barrier(0);
    }
}
DI void conv_oct(const bf16_t* src, size_t pitch, int tfirst, const float* w, int wpitch, const float* bias, u32x4 (&yr)[8]) {
    u32x4 x[11];
#pragma unroll
    for (int j = 0; j < 11; ++j) { x[j] = (u32x4){0u, 0u, 0u, 0u}; if (tfirst + j >= 0) x[j] = *(const u32x4*)(src + (size_t)j * pitch); }
    f32x4 wl[4][2], bl[2]; conv_oct_weights(w, wpitch, bias, wl, bl); conv_oct_apply(x, wl, bl, yr);
}
DI unsigned u4half(const u32x4 v, int c) { const unsigned w = (c >> 1) == 0 ? v.x : (c >> 1) == 1 ? v.y : (c >> 1) == 2 ? v.z : v.w; return (c & 1) ? (w >> 16) : (w & 0xffffu); }
DI u32x4 pack_col(const u32x4 (&yr)[8], int c) { u32x4 o; o.x = u4half(yr[0], c) | (u4half(yr[1], c) << 16); o.y = u4half(yr[2], c) | (u4half(yr[3], c) << 16);
    o.z = u4half(yr[4], c) | (u4half(yr[5], c) << 16); o.w = u4half(yr[6], c) | (u4half(yr[7], c) << 16); return o; }
DI void transpose_oct(const bf16_t* src, size_t pitch, LAS bf16_t* dst, int dpitch, int c0, int l0) {
    u32x4 x[8];
#pragma unroll
    for (int j = 0; j < 8; ++j) x[j] = *(const u32x4*)(src + (size_t)j * pitch);
#pragma unroll
    for (int c = 0; c < 8; ++c) { u32x4 o; const int wi = c >> 1; unsigned e[8];
#pragma unroll
        for (int j = 0; j < 8; ++j) { const unsigned wv = wi == 0 ? x[j].x : wi == 1 ? x[j].y : wi == 2 ? x[j].z : x[j].w; e[j] = (c & 1) ? (wv >> 16) : (wv & 0xffffu); }
        o.x = e[0] | (e[1] << 16); o.y = e[2] | (e[3] << 16); o.z = e[4] | (e[5] << 16); o.w = e[6] | (e[7] << 16);
        *(LAS u32x4*)(dst + (c0 + c) * dpitch + l0) = o; }
}

constexpr int L0_UNITS = NCHT * 6;
#define L0_RS ((bf16_t*)F.out)
#define L0_SS ((bf16_t*)F.out + (size_t)NCHT * 65536)
#define L0_CDS WSP(float, WS_LAC)
#define L0_QKR WSP(bf16_t, WS_XN)
DI float ret_gamma_log2(int h) { return log2f(1.0f - exp2f(-5.0f - (float)h)); }

template <class Put> DI void ssd_conv_pair(Frame& F, long tok0, int t0, int xc, int l0, const Put& put) {
    const bf16_t* P = WSP(bf16_t, WS_PROJ) + 2560 + xc; float wa[4], wb[4];
#pragma unroll
    for (int j = 0; j < 4; ++j) { wa[j] = F.in[3][j * 1024 + xc]; wb[j] = F.in[3][j * 1024 + xc + 1]; }
    const float ba = F.in[4][xc], bb = F.in[4][xc + 1]; float xa[3], xb[3];
#pragma unroll
    for (int j = 0; j < 3; ++j) { const int l = l0 - 3 + j; unsigned v = 0u; if (t0 + l >= 0) v = *(const unsigned*)(P + (size_t)(tok0 + l) * N0); xa[j] = __uint_as_float(v << 16); xb[j] = __uint_as_float(v & 0xffff0000u); }
#pragma unroll 4
    for (int l = l0; l < l0 + 32; ++l) { const unsigned v = *(const unsigned*)(P + (size_t)(tok0 + l) * N0); const float ca = __uint_as_float(v << 16), cb = __uint_as_float(v & 0xffff0000u);
        const float ya = silu_f(ba + wa[0] * xa[0] + wa[1] * xa[1] + wa[2] * xa[2] + wa[3] * ca), yb = silu_f(bb + wb[0] * xb[0] + wb[1] * xb[1] + wb[2] * xb[2] + wb[3] * cb);
        xa[0] = xa[1]; xa[1] = xa[2]; xa[2] = ca; xb[0] = xb[1]; xb[1] = xb[2]; xb[2] = cb; put(l, ya, yb); }
}
DI void ssd_lacum_v(Frame& F, int g, int lane, const float (&dtv)[4], LAS float* LC, LAS float* DTL) {
#pragma unroll
    for (int hh = 0; hh < 4; ++hh) { const int h = 4 * g + hh; const float dt = dtv[hh]; float x = dt * -expf(F.in[6][h]);
#pragma unroll
        for (int o = 1; o < 64; o <<= 1) { const float t = __shfl_up(x, o); if (lane >= o) x += t; }
        LC[hh * 64 + lane] = x; DTL[hh * 64 + lane] = dt; }
}
DI void ssd_lacum(Frame& F, long tok0, int g, int lane, LAS float* LC, LAS float* DTL) {
#pragma unroll
    for (int hh = 0; hh < 4; ++hh) { const int h = 4 * g + hh; const float dt = WSP(float, WS_DT)[(size_t)(tok0 + lane) * 8 + h]; float x = dt * -expf(F.in[6][h]);
#pragma unroll
        for (int o = 1; o < 64; o <<= 1) { const float t = __shfl_up(x, o); if (lane >= o) x += t; }
        LC[hh * 64 + lane] = x; DTL[hh * 64 + lane] = dt; }
}

DI void l0_phase_a(Frame& F) {
    LAS unsigned char* lds = F.lds; const int w = F.wave;
    LAS bf16_t* AT_ = (LAS bf16_t*)lds;
    LAS bf16_t* BT_ = (LAS bf16_t*)(lds + 18432);
    LAS float* LC = (LAS float*)(lds + 18432 + 36864);
    LAS float* DTL = LC + 256;
    bf16_t* P0 = WSP(bf16_t, WS_PROJ); const f32x2* rope = WSP(f32x2, WS_ROPE);
    for (int u = blockIdx.x; u < L0_UNITS; u += F.G) {
        int tid = F.tid; OPAQUE_V(tid); const int lane = tid & 63, fr = lane & 15, fq = lane >> 4;
        const int ch = u / 6, sub = u % 6; const long tok0 = (long)ch * 64; const int t0 = (int)(tok0 % L);
        const bool lastu = u + 3 * F.G >= L0_UNITS;
        if (sub < 4) {
            const int h = sub; const float lg2 = ret_gamma_log2(h);
            {
                const int io = tid & 7, l = tid >> 3; const bf16_t* sq = P0 + (size_t)(tok0 + l) * N0 + h * 128 + 8 * io; const bf16_t* sk = sq + 512; bf16_t* pq = L0_QKR + (size_t)(tok0 + l) * 1024 + h * 128 + 8 * io; bf16_t* pk = pq + 512;
                const u32x4 q1 = *(const u32x4*)sq, q2 = *(const u32x4*)(sq + 64), k1 = *(const u32x4*)sk, k2 = *(const u32x4*)(sk + 64);
                const f32x4* rp = (const f32x4*)(rope + (size_t)(t0 + l) * 64 + 8 * io); const f32x4 r0 = rp[0], r1 = rp[1], r2 = rp[2], r3 = rp[3];
                const float cs[16] = {r0[0], r0[1], r0[2], r0[3], r1[0], r1[1], r1[2], r1[3], r2[0], r2[1], r2[2], r2[3], r3[0], r3[1], r3[2], r3[3]};
                float oq1[8], oq2[8], ok1[8], ok2[8];
#pragma unroll
                for (int c = 0; c < 8; ++c) { const float co = cs[2 * c], si = cs[2 * c + 1]; const float a1 = u4elem(q1, c), a2 = u4elem(q2, c), b1 = u4elem(k1, c), b2 = u4elem(k2, c);
                    oq1[c] = (a1 * co - a2 * si) * 0.08838834764831845f; oq2[c] = (a1 * si + a2 * co) * 0.08838834764831845f; ok1[c] = b1 * co - b2 * si; ok2[c] = b1 * si + b2 * co; }
                u32x4 w; w.x = pk2(oq1[0], oq1[1]); w.y = pk2(oq1[2], oq1[3]); w.z = pk2(oq1[4], oq1[5]); w.w = pk2(oq1[6], oq1[7]); if (lastu) store16_wt(pq, w); else *(u32x4*)pq = w;
                w.x = pk2(oq2[0], oq2[1]); w.y = pk2(oq2[2], oq2[3]); w.z = pk2(oq2[4], oq2[5]); w.w = pk2(oq2[6], oq2[7]); if (lastu) store16_wt(pq + 64, w); else *(u32x4*)(pq + 64) = w;
                w.x = pk2(ok1[0], ok1[1]); w.y = pk2(ok1[2], ok1[3]); w.z = pk2(ok1[4], ok1[5]); w.w = pk2(ok1[6], ok1[7]); if (lastu) store16_wt(pk, w); else *(u32x4*)pk = w;
                w.x = pk2(ok2[0], ok2[1]); w.y = pk2(ok2[2], ok2[3]); w.z = pk2(ok2[4], ok2[5]); w.w = pk2(ok2[6], ok2[7]); if (lastu) store16_wt(pk + 64, w); else *(u32x4*)(pk + 64) = w;
                const float kw = __builtin_amdgcn_exp2f(lg2 * (float)(63 - l));
#pragma unroll
                for (int c = 0; c < 8; ++c) { const int ls = (((l >> 3) ^ io) << 3) | (l & 7);
                    AT_[(8 * io + c) * 72 + ls] = f2bf(bf2f(f2bf(ok1[c])) * kw); AT_[(64 + 8 * io + c) * 72 + ls] = f2bf(bf2f(f2bf(ok2[c])) * kw); }
            }
            if (tid < 128) { const int eo = tid & 15, rg = tid >> 4; transpose_oct(P0 + (size_t)(tok0 + 8 * rg) * N0 + 1024 + h * 128 + 8 * eo, N0, BT_, 72, 8 * eo, 8 * rg); }
            __syncthreads();
            {
                const int sw = (2 * w + (fr >> 3)) & 7;
                const bf16x8 a0 = ldsfrag(AT_, 16 * w + fr, 8 * (fq ^ sw), 72), a1 = ldsfrag(AT_, 16 * w + fr, 8 * ((4 + fq) ^ sw), 72);
                bf16_t* rs = L0_RS + ((size_t)ch * 4 + h) * 16384;
                bf16x8 bfr[8][2];
#pragma unroll
                for (int n = 0; n < 8; ++n) { bfr[n][0] = ldsfrag(BT_, 16 * n + fr, 8 * fq, 72); bfr[n][1] = ldsfrag(BT_, 16 * n + fr, 32 + 8 * fq, 72); }
                __builtin_amdgcn_sched_barrier(0);
#pragma unroll
                for (int n = 0; n < 8; ++n) { f32x4 acc = {0.f, 0.f, 0.f, 0.f};
                    acc = __builtin_amdgcn_mfma_f32_16x16x32_bf16(a0, bfr[n][0], acc, 0, 0, 0);
                    acc = __builtin_amdgcn_mfma_f32_16x16x32_bf16(a1, bfr[n][1], acc, 0, 0, 0);
                    u32x2 o; o.x = cvt_pk_bf16(acc[0], acc[1]); o.y = cvt_pk_bf16(acc[2], acc[3]); *(u32x2*)(rs + (size_t)(16 * n + fr) * 128 + 16 * w + 4 * fq) = o; }
            }
            __syncthreads();
        } else {
            const int g = sub - 4;
            if (w == 7) ssd_lacum(F, tok0, g, lane, LC, DTL);
            __syncthreads();
            if (tid < 384) { const int oc = tid % 48, rg = tid / 48, c0 = 8 * oc, l0 = 8 * rg; u32x4 y[8];
                const int xc = c0 < 256 ? 256 * g + c0 : 512 + 128 * g + c0 - 256;
                conv_oct(WSP(bf16_t, WS_PROJ) + (size_t)(tok0 + l0 - 3) * N0 + 2560 + xc, N0, t0 + l0 - 3, F.in[3] + xc, 1024, F.in[4] + xc, y);
                if (c0 < 256) { const int hh = c0 >> 6; const float lal = LC[hh * 64 + 63]; float sc[8];
#pragma unroll
                    for (int r = 0; r < 8; ++r) sc[r] = DTL[hh * 64 + l0 + r] * __expf(lal - LC[hh * 64 + l0 + r]);
#pragma unroll
                    for (int c = 0; c < 8; ++c) { u32x4 o; o.x = pk2(u4elem(y[0], c) * sc[0], u4elem(y[1], c) * sc[1]); o.y = pk2(u4elem(y[2], c) * sc[2], u4elem(y[3], c) * sc[3]); o.z = pk2(u4elem(y[4], c) * sc[4], u4elem(y[5], c) * sc[5]); o.w = pk2(u4elem(y[6], c) * sc[6], u4elem(y[7], c) * sc[7]);
                        *(LAS u32x4*)(BT_ + (c0 + c) * 72 + ((rg ^ (oc & 7)) << 3)) = o; }
                } else { const int n0 = c0 - 256;
#pragma unroll
                    for (int c = 0; c < 8; ++c) *(LAS u32x4*)(AT_ + (n0 + c) * 72 + ((rg ^ (oc & 7)) << 3)) = pack_col(y, c); }
            } else if (tid < 388) { const int hh = tid - 384; L0_CDS[(size_t)ch * 8 + 4 * g + hh] = expf(LC[hh * 64 + 63]); }
            __syncthreads();
            {
                const int swa = (2 * w + (fr >> 3)) & 7;
                const bf16x8 a0 = ldsfrag(AT_, 16 * w + fr, 8 * (fq ^ swa), 72), a1 = ldsfrag(AT_, 16 * w + fr, 8 * ((4 + fq) ^ swa), 72);
#pragma unroll 1
                for (int c4 = 0; c4 < 4; ++c4) { bf16x8 bfr[4][2];
#pragma unroll
                    for (int q = 0; q < 4; ++q) { const int swb = (2 * q + (fr >> 3)) & 7; bfr[q][0] = ldsfrag(BT_, 16 * (4 * c4 + q) + fr, 8 * (fq ^ swb), 72); bfr[q][1] = ldsfrag(BT_, 16 * (4 * c4 + q) + fr, 8 * ((4 + fq) ^ swb), 72); }
                    __builtin_amdgcn_sched_barrier(0);
#pragma unroll
                    for (int q = 0; q < 4; ++q) { f32x4 acc = {0.f, 0.f, 0.f, 0.f};
                        acc = __builtin_amdgcn_mfma_f32_16x16x32_bf16(a0, bfr[q][0], acc, 0, 0, 0);
                        acc = __builtin_amdgcn_mfma_f32_16x16x32_bf16(a1, bfr[q][1], acc, 0, 0, 0);
                        u32x2 o; o.x = cvt_pk_bf16(acc[0], acc[1]); o.y = cvt_pk_bf16(acc[2], acc[3]);
                        *(u32x2*)(L0_SS + (((size_t)ch * 8 + 4 * g + c4) * 64 + 16 * q + fr) * 128 + 16 * w + 4 * fq) = o; } }
            }
            __syncthreads();
        }
    }
}
DI void l0_phase_b(Frame& F) {
    constexpr int NC = L / 64, NB = NC < 64 ? (NC < 32 ? (NC < 16 ? NC / 2 : 8) : 16) : 32; static_assert(NB >= 1 && NC % (2 * NB) == 0, "phase b batches");
    for (long id = F.gtid; id < 2L * 65536; id += F.gthreads) {
        const int b = (int)(id >> 16), e = (int)(id & 65535); float s0 = 0.f, s1 = 0.f;
        if (e < 32768) { const int h = e >> 13; const float dec = exp2f(ret_gamma_log2(h) * 64.0f); unsigned* p = (unsigned*)L0_RS + (size_t)b * NC * 32768 + e; unsigned v[NB], w[NB];
#pragma unroll
            for (int k = 0; k < NB; ++k) v[k] = p[(size_t)k * 32768];
#pragma unroll 1
            for (int c = 0; c < NC; c += 2 * NB) {
#pragma unroll
                for (int k = 0; k < NB; ++k) w[k] = p[(size_t)(c + NB + k) * 32768];
#pragma unroll
                for (int k = 0; k < NB; ++k) { store4u_wt(p + (size_t)(c + k) * 32768, pk2(s0, s1)); s0 = s0 * dec + __uint_as_float(v[k] << 16); s1 = s1 * dec + __uint_as_float(v[k] & 0xffff0000u); }
                if (c + 2 * NB < NC) {
#pragma unroll
                    for (int k = 0; k < NB; ++k) v[k] = p[(size_t)(c + 2 * NB + k) * 32768]; }
#pragma unroll
                for (int k = 0; k < NB; ++k) { store4u_wt(p + (size_t)(c + NB + k) * 32768, pk2(s0, s1)); s0 = s0 * dec + __uint_as_float(w[k] << 16); s1 = s1 * dec + __uint_as_float(w[k] & 0xffff0000u); } }
        } else { const int e2 = e - 32768, h = e2 >> 12; unsigned* p = (unsigned*)L0_SS + (size_t)b * NC * 32768 + e2; const float* cd = L0_CDS + (size_t)b * NC * 8 + h; unsigned v[NB], w[NB]; float dv[NB], dw[NB];
#pragma unroll
            for (int k = 0; k < NB; ++k) { v[k] = p[(size_t)k * 32768]; dv[k] = cd[k * 8]; }
#pragma unroll 1
            for (int c = 0; c < NC; c += 2 * NB) {
#pragma unroll
                for (int k = 0; k < NB; ++k) { w[k] = p[(size_t)(c + NB + k) * 32768]; dw[k] = cd[(c + NB + k) * 8]; }
#pragma unroll
                for (int k = 0; k < NB; ++k) { store4u_wt(p + (size_t)(c + k) * 32768, pk2(s0, s1)); s0 = s0 * dv[k] + __uint_as_float(v[k] << 16); s1 = s1 * dv[k] + __uint_as_float(v[k] & 0xffff0000u); }
                if (c + 2 * NB < NC) {
#pragma unroll
                    for (int k = 0; k < NB; ++k) { v[k] = p[(size_t)(c + 2 * NB + k) * 32768]; dv[k] = cd[(c + 2 * NB + k) * 8]; } }
#pragma unroll
                for (int k = 0; k < NB; ++k) { store4u_wt(p + (size_t)(c + NB + k) * 32768, pk2(s0, s1)); s0 = s0 * dw[k] + __uint_as_float(w[k] << 16); s1 = s1 * dw[k] + __uint_as_float(w[k] & 0xffff0000u); } }
        }
    }
}
struct RetPf { u32x4 qk[4], kv[4]; unsigned vv[8]; };
DI void ret_issue(Frame& F, int ur, int tid, RetPf& r) {
    const int ch = ur >> 2, h = ur & 3; const size_t tok0 = (size_t)ch * 64; const bf16_t* P0 = WSP(bf16_t, WS_PROJ);
#pragma unroll
    for (int j = 0; j < 4; ++j) { const int it = tid + NTHREADS * j, c16 = it & 15, l = (it >> 4) & 63, which = it >> 10;
        r.qk[j] = *(const u32x4*)(L0_QKR + (tok0 + l) * 1024 + which * 512 + h * 128 + 8 * c16); }
#pragma unroll
    for (int j = 0; j < 4; ++j) { const int it = tid + NTHREADS * j, c16 = it & 15, e = it >> 4; r.kv[j] = *(const u32x4*)(L0_RS + (((size_t)ch * 4 + h) * 128 + e) * 128 + 8 * c16); }
    const int e2 = tid & 63, rg = tid >> 6;
#pragma unroll
    for (int j = 0; j < 8; ++j) r.vv[j] = *(const unsigned*)(P0 + (tok0 + 8 * rg + j) * N0 + 1024 + h * 128 + 2 * e2);
}
DI void ret_commit(LAS unsigned char* lds, int tid, const RetPf& r) {
    LAS bf16_t* QS = (LAS bf16_t*)lds; LAS bf16_t* KS = (LAS bf16_t*)(lds + 17408); LAS bf16_t* VT = (LAS bf16_t*)(lds + 34816); LAS bf16_t* KV = (LAS bf16_t*)(lds + 53248);
#pragma unroll
    for (int j = 0; j < 4; ++j) { const int it = tid + NTHREADS * j, c16 = it & 15, l = (it >> 4) & 63, which = it >> 10; *(LAS u32x4*)((which ? KS : QS) + l * 136 + 8 * c16) = r.qk[j]; }
#pragma unroll
    for (int j = 0; j < 4; ++j) { const int it = tid + NTHREADS * j, c16 = it & 15, e = it >> 4; *(LAS u32x4*)(KV + e * 136 + 8 * c16) = r.kv[j]; }
    const int e2 = tid & 63, rg = tid >> 6;
    { u32x4 o; o.x = (r.vv[0] & 0xffffu) | (r.vv[1] << 16); o.y = (r.vv[2] & 0xffffu) | (r.vv[3] << 16); o.z = (r.vv[4] & 0xffffu) | (r.vv[5] << 16); o.w = (r.vv[6] & 0xffffu) | (r.vv[7] << 16);
      *(LAS u32x4*)(VT + (2 * e2) * 72 + 8 * rg) = o; }
    { u32x4 o; o.x = (r.vv[0] >> 16) | (r.vv[1] & 0xffff0000u); o.y = (r.vv[2] >> 16) | (r.vv[3] & 0xffff0000u); o.z = (r.vv[4] >> 16) | (r.vv[5] & 0xffff0000u); o.w = (r.vv[6] >> 16) | (r.vv[7] & 0xffff0000u);
      *(LAS u32x4*)(VT + (2 * e2 + 1) * 72 + 8 * rg) = o; }
}
struct SsdPf { u32x4 x[11]; u32x4 pv[4]; float dtv[4]; };
DI int ssd_xc(int g, int c0) { return c0 < 256 ? 256 * g + c0 : c0 < 384 ? 512 + 128 * g + c0 - 256 : 768 + 128 * g + c0 - 384; }
DI void ssd_issue(Frame& F, int us, int tid, SsdPf& r) {
    const int ch = us >> 1, g = us & 1; const long tok0 = (long)ch * 64; const int t0 = (int)(tok0 % L);
    const int oc = tid & 63, rg = tid >> 6, c0 = 8 * oc, l0 = 8 * rg; const int xc = ssd_xc(g, c0);
    const bf16_t* src = WSP(bf16_t, WS_PROJ) + (tok0 + l0 - 3) * (long)N0 + 2560 + xc;
#pragma unroll
    for (int j = 0; j < 11; ++j) { r.x[j] = (u32x4){0u, 0u, 0u, 0u}; if (t0 + l0 - 3 + j >= 0) r.x[j] = *(const u32x4*)(src + (size_t)j * N0); }
    const bf16_t* ssb = L0_SS + ((size_t)ch * 8 + 4 * g) * 8192;
#pragma unroll
    for (int j = 0; j < 4; ++j) { const int q = tid + NTHREADS * j; r.pv[j] = *(const u32x4*)(ssb + (size_t)(q >> 4) * 128 + 8 * (q & 15)); }
    if (F.wave == 7) {
#pragma unroll
        for (int hh = 0; hh < 4; ++hh) r.dtv[hh] = WSP(float, WS_DT)[(size_t)(tok0 + (tid & 63)) * 8 + 4 * g + hh]; }
}

DI void l0_phase_c(Frame& F) {
    LAS unsigned char* lds = F.lds; const int w = F.wave;
    bf16_t* P0 = WSP(bf16_t, WS_PROJ); bf16_t* mix = WSP(bf16_t, WS_MIX);
    {
        RetPf pf; if ((int)blockIdx.x < NCHT * 4) ret_issue(F, blockIdx.x, F.tid, pf);
        for (int ur = blockIdx.x; ur < NCHT * 4; ur += F.G) {
            int tid = F.tid; OPAQUE_V(tid); const int lane = tid & 63, fr = lane & 15, fq = lane >> 4;
            const int ch = ur >> 2, h = ur & 3; const long tok0 = (long)ch * 64; const float lg2 = ret_gamma_log2(h);
            LAS bf16_t* QS = (LAS bf16_t*)lds;
            LAS bf16_t* KS = (LAS bf16_t*)(lds + 17408);
            LAS bf16_t* VT = (LAS bf16_t*)(lds + 34816);
            LAS bf16_t* KV = (LAS bf16_t*)(lds + 53248);
            LAS bf16_t* SC = (LAS bf16_t*)(lds + 88064);
            LAS float* PART = (LAS float*)(lds + 97280);
            ret_commit(lds, tid, pf);
            __syncthreads();
            bf16_t gt[4][4];
#pragma unroll
            for (int r = 0; r < 4; ++r)
#pragma unroll
                for (int n = 0; n < 4; ++n) gt[r][n] = P0[(size_t)(tok0 + 16 * (w & 3) + 4 * fq + r) * N0 + 1536 + h * 128 + 16 * (4 * (w >> 2) + n) + fr];
            if (ur + F.G < NCHT * 4) ret_issue(F, ur + F.G, tid, pf);
            {
                const int ti = w >> 1, jp = w & 1; f32x4 s0 = {0.f, 0.f, 0.f, 0.f}, s1 = s0;
                bf16x8 fa[4], fb0[4], fb1[4];
#pragma unroll
                for (int kx = 0; kx < 4; ++kx) { fa[kx] = ldsfrag(QS, 16 * ti + fr, 32 * kx + 8 * fq, 136); fb0[kx] = ldsfrag(KS, 32 * jp + fr, 32 * kx + 8 * fq, 136); fb1[kx] = ldsfrag(KS, 32 * jp + 16 + fr, 32 * kx + 8 * fq, 136); }
                __builtin_amdgcn_sched_barrier(0);
#pragma unroll
                for (int kx = 0; kx < 4; ++kx) { s0 = __builtin_amdgcn_mfma_f32_16x16x32_bf16(fa[kx], fb0[kx], s0, 0, 0, 0); s1 = __builtin_amdgcn_mfma_f32_16x16x32_bf16(fa[kx], fb1[kx], s1, 0, 0, 0); }
#pragma unroll
                for (int jj = 0; jj < 2; ++jj) { const int s = 32 * jp + 16 * jj + fr; const f32x4 v = jj ? s1 : s0;
#pragma unroll
                    for (int r = 0; r < 4; ++r) { const int l = 16 * ti + 4 * fq + r; SC[l * 72 + s] = f2bf(s <= l ? v[r] * __builtin_amdgcn_exp2f(lg2 * (float)(l - s)) : 0.f); } }
            }
            __syncthreads();
            {
                const int ti = w & 3, half = w >> 2; f32x4 y[4]; float ss[4] = {0.f, 0.f, 0.f, 0.f};
                bf16x8 aq[4], as[2];
#pragma unroll
                for (int kx = 0; kx < 4; ++kx) aq[kx] = ldsfrag(QS, 16 * ti + fr, 32 * kx + 8 * fq, 136);
                as[0] = ldsfrag(SC, 16 * ti + fr, 8 * fq, 72); as[1] = ldsfrag(SC, 16 * ti + fr, 32 + 8 * fq, 72);
                bf16x8 bv[4][2], bk[4][4];
#pragma unroll
                for (int n = 0; n < 4; ++n) { const int er = 16 * (4 * half + n) + fr; bv[n][0] = ldsfrag(VT, er, 8 * fq, 72); bv[n][1] = ldsfrag(VT, er, 32 + 8 * fq, 72);
#pragma unroll
                    for (int kx = 0; kx < 4; ++kx) bk[n][kx] = ldsfrag(KV, er, 32 * kx + 8 * fq, 136); }
                __builtin_amdgcn_sched_barrier(0);
#pragma unroll
                for (int n = 0; n < 4; ++n) { f32x4 a1 = {0.f, 0.f, 0.f, 0.f}, a2 = a1;
                    a1 = __builtin_amdgcn_mfma_f32_16x16x32_bf16(as[0], bv[n][0], a1, 0, 0, 0); a1 = __builtin_amdgcn_mfma_f32_16x16x32_bf16(as[1], bv[n][1], a1, 0, 0, 0);
#pragma unroll
                    for (int kx = 0; kx < 4; ++kx) a2 = __builtin_amdgcn_mfma_f32_16x16x32_bf16(aq[kx], bk[n][kx], a2, 0, 0, 0);
#pragma unroll
                    for (int r = 0; r < 4; ++r) { const float v = a1[r] + a2[r] * __builtin_amdgcn_exp2f(lg2 * (float)(16 * ti + 4 * fq + r + 1)); y[n][r] = v; ss[r] += v * v; } }
#pragma unroll
                for (int r = 0; r < 4; ++r) { float v = ss[r]; v += __shfl_xor(v, 1); v += __shfl_xor(v, 2); v += __shfl_xor(v, 4); v += __shfl_xor(v, 8); if (fr == 0) PART[(16 * ti + 4 * fq + r) * 2 + half] = v; }
                __syncthreads();
#pragma unroll
                for (int r = 0; r < 4; ++r) { const int l = 16 * ti + 4 * fq + r; const float rr = __builtin_amdgcn_rsqf((PART[l * 2] + PART[l * 2 + 1]) * (1.0f / 128.0f) + EPS); const size_t tok = (size_t)(tok0 + l);
#pragma unroll
                    for (int n = 0; n < 4; ++n) { const int e = 16 * (4 * half + n) + fr; mix[tok * 1024 + h * 128 + e] = f2bf(silu_f(bf2f(gt[r][n])) * y[n][r] * rr); } }
            }
            __syncthreads();
        }
    }
    {
        SsdPf pf; if ((int)blockIdx.x < NCHT * 2) ssd_issue(F, blockIdx.x, F.tid, pf);
        for (int us = blockIdx.x; us < NCHT * 2; us += F.G) {
            int tid = F.tid; OPAQUE_V(tid); const int lane = tid & 63, fr = lane & 15, fq = lane >> 4;
            const int ch = us >> 1, g = us & 1; const long tok0 = (long)ch * 64;
            LAS bf16_t* XT = (LAS bf16_t*)lds;
            LAS bf16_t* CM = (LAS bf16_t*)(lds + 36864);
            LAS bf16_t* SH = (LAS bf16_t*)(lds + 54272);
            LAS float* LC = (LAS float*)(lds + 91136);
            LAS float* DTL = LC + 256;
            LAS float* PART = LC + 512;
            LAS bf16_t* PV = (LAS bf16_t*)(lds + 93696);
            LAS bf16_t* BM = (LAS bf16_t*)(lds + 128512);
            const bf16_t* ssb = L0_SS + ((size_t)ch * 8 + 4 * g) * 8192;
            f32x4 cwl[4][2], cbl[2]; { const int xc = ssd_xc(g, 8 * (tid & 63)); conv_oct_weights(F.in[3] + xc, 1024, F.in[4] + xc, cwl, cbl); }
            if (w == 7) ssd_lacum_v(F, g, lane, pf.dtv, LC, DTL);
            { const int oc = tid & 63, rg = tid >> 6, c0 = 8 * oc, l0 = 8 * rg; u32x4 y[8];
                conv_oct_apply(pf.x, cwl, cbl, y);
                if (c0 < 256) {
#pragma unroll
                    for (int c = 0; c < 8; ++c) *(LAS u32x4*)(XT + (c0 + c) * 72 + ((rg ^ (oc & 7)) << 3)) = pack_col(y, c);
                } else { LAS bf16_t* dst = c0 < 384 ? BM + c0 - 256 : CM + c0 - 384;
#pragma unroll
                    for (int r = 0; r < 8; ++r) *(LAS u32x4*)(dst + (l0 + r) * 136) = y[r]; } }
            u32x4 pv[4];
#pragma unroll
            for (int j = 0; j < 4; ++j) { const int q = tid + NTHREADS * j; *(LAS u32x4*)(PV + (q >> 4) * 136 + 8 * (q & 15)) = pf.pv[j]; pv[j] = *(const u32x4*)(ssb + (size_t)(128 + (q >> 4)) * 128 + 8 * (q & 15)); }
            __syncthreads();
            bf16_t zz[2][4][4];
            { const int l0r = 16 * (w & 3) + 4 * fq, hs = w >> 2;
#pragma unroll
            for (int rd = 0; rd < 2; ++rd)
#pragma unroll
                for (int pt = 0; pt < 4; ++pt)
#pragma unroll
                    for (int r = 0; r < 4; ++r) zz[rd][pt][r] = P0[(size_t)(tok0 + l0r + r) * N0 + 2048 + 256 * g + (2 * rd + hs) * 64 + 16 * pt + fr]; }
            if (us + F.G < NCHT * 2) ssd_issue(F, us + F.G, tid, pf);
            {
                const int ti = w >> 1, jp = w & 1; f32x4 s0 = {0.f, 0.f, 0.f, 0.f}, s1 = s0;
                bf16x8 fa[4], fb0[4], fb1[4];
#pragma unroll
                for (int kx = 0; kx < 4; ++kx) { fa[kx] = ldsfrag(CM, 16 * ti + fr, 32 * kx + 8 * fq, 136); fb0[kx] = ldsfrag(BM, 32 * jp + fr, 32 * kx + 8 * fq, 136); fb1[kx] = ldsfrag(BM, 32 * jp + 16 + fr, 32 * kx + 8 * fq, 136); }
                __builtin_amdgcn_sched_barrier(0);
#pragma unroll
                for (int kx = 0; kx < 4; ++kx) { s0 = __builtin_amdgcn_mfma_f32_16x16x32_bf16(fa[kx], fb0[kx], s0, 0, 0, 0); s1 = __builtin_amdgcn_mfma_f32_16x16x32_bf16(fa[kx], fb1[kx], s1, 0, 0, 0); }
#pragma unroll
                for (int hh = 0; hh < 4; ++hh)
#pragma unroll
                    for (int jj = 0; jj < 2; ++jj) { const int s = 32 * jp + 16 * jj + fr; const f32x4 v = jj ? s1 : s0; const float las = LC[hh * 64 + s], dts = DTL[hh * 64 + s], dsk = F.in[7][4 * g + hh];
#pragma unroll
                        for (int r = 0; r < 4; ++r) { const int l = 16 * ti + 4 * fq + r;
                            SH[(hh * 64 + l) * 72 + s] = f2bf(s <= l ? v[r] * __expf(LC[hh * 64 + l] - las) * dts + (s == l ? dsk : 0.f) : 0.f); } }
            }
            __syncthreads();
            {
                const int ti = w & 3, hs = w >> 2, l0r = 16 * ti + 4 * fq; bf16x8 ac[4]; f32x4 yv[2][4]; f32x4 ss = {0.f, 0.f, 0.f, 0.f};
#pragma unroll
                for (int kx = 0; kx < 4; ++kx) ac[kx] = ldsfrag(CM, 16 * ti + fr, 32 * kx + 8 * fq, 136);
#pragma unroll
                for (int rd = 0; rd < 2; ++rd) { const int hh = 2 * rd + hs;
                    const bf16x8 sh0 = ldsfrag(SH, hh * 64 + 16 * ti + fr, 8 * fq, 72), sh1 = ldsfrag(SH, hh * 64 + 16 * ti + fr, 32 + 8 * fq, 72);
#pragma unroll
                    for (int pt = 0; pt < 4; ++pt) { const int pr = 16 * pt + fr; bf16x8 bx[2], bp[4];
                        const int swx = (2 * pt + (fr >> 3)) & 7; bx[0] = ldsfrag(XT, hh * 64 + pr, 8 * (fq ^ swx), 72); bx[1] = ldsfrag(XT, hh * 64 + pr, 8 * ((4 + fq) ^ swx), 72);
#pragma unroll
                        for (int kx = 0; kx < 4; ++kx) bp[kx] = ldsfrag(PV, hs * 64 + pr, 32 * kx + 8 * fq, 136);
                        __builtin_amdgcn_sched_barrier(0);
                        f32x4 a1 = {0.f, 0.f, 0.f, 0.f}, a2 = a1;
                        a1 = __builtin_amdgcn_mfma_f32_16x16x32_bf16(sh0, bx[0], a1, 0, 0, 0); a1 = __builtin_amdgcn_mfma_f32_16x16x32_bf16(sh1, bx[1], a1, 0, 0, 0);
#pragma unroll
                        for (int kx = 0; kx < 4; ++kx) a2 = __builtin_amdgcn_mfma_f32_16x16x32_bf16(ac[kx], bp[kx], a2, 0, 0, 0);
#pragma unroll
                        for (int r = 0; r < 4; ++r) { const int l = l0r + r; const float v = (a1[r] + a2[r] * __expf(LC[hh * 64 + l])) * silu_f(bf2f(zz[rd][pt][r])); yv[rd][pt][r] = v; ss[r] += v * v; } }
                    if (rd == 0) { __syncthreads();
#pragma unroll
                        for (int j = 0; j < 4; ++j) { const int q = tid + NTHREADS * j; *(LAS u32x4*)(PV + (q >> 4) * 136 + 8 * (q & 15)) = pv[j]; }
                        __syncthreads(); } }
#pragma unroll
                for (int r = 0; r < 4; ++r) { float v = ss[r]; v += __shfl_xor(v, 1); v += __shfl_xor(v, 2); v += __shfl_xor(v, 4); v += __shfl_xor(v, 8); if (fr == 0) PART[(l0r + r) * 2 + hs] = v; }
                __syncthreads();
                bf16_t* mrow = mix + (size_t)(tok0 + l0r) * 1024 + 512 + 256 * g + fr;
#pragma unroll
                for (int r = 0; r < 4; ++r) { const float rr = __builtin_amdgcn_rsqf((PART[(l0r + r) * 2] + PART[(l0r + r) * 2 + 1]) * (1.0f / 256.0f) + EPS);
#pragma unroll
                    for (int rd = 0; rd < 2; ++rd)
#pragma unroll
                        for (int pt = 0; pt < 4; ++pt) { const int c = (2 * rd + hs) * 64 + 16 * pt; mrow[(size_t)r * 1024 + c] = f2bf(yv[rd][pt][r] * rr * F.in[8][256 * g + c + fr]); } }
            }
            __syncthreads();
        }
    }
}

#define P1B WSP(bf16_t, WS_PROJ)
#define QC WSP(bf16_t, WS_PROJ + (size_t)T * N1 * 2)
#define KC WSP(bf16_t, WS_TAIL)
#define VC WSP(bf16_t, WS_XN)
#define YG WSP(bf16_t, WS_YG)
DI void l1_conv(Frame& F, int c_lo, int c_hi) {
    const int nc = c_hi - c_lo;
    for (long idx = F.gtid; idx < (long)T * nc; idx += F.gthreads) {
        const int c = c_lo + (int)(idx % nc); const long tok = idx / nc; const int t = (int)(tok % L);
        float a = 0.f;
#pragma unroll
        for (int j = 0; j < 4; ++j) if (t - 3 + j >= 0) a += F.in[15][j * 2304 + c] * bf2f(P1B[(size_t)(tok - 3 + j) * N1 + c]);
        const bf16_t o = f2bf(silu_f(a));
        if (c < 768) QC[(size_t)tok * 768 + c] = o; else if (c < 1536) KC[(size_t)tok * 768 + c - 768] = o; else VC[(size_t)tok * 768 + c - 1536] = o;
    }
}
DI void l1_gdn_ba(Frame& F) {
    for (long idx = F.gtid; idx < (long)T * 12; idx += F.gthreads) {
        const int j = (int)(idx % 12); const size_t tok = (size_t)(idx / 12); const bf16_t* xr = WSP(bf16_t, WS_XN) + tok * D; float a = 0.f;
        for (int k = 0; k < D; ++k) a += bf2f(xr[k]) * F.in[13][k] * F.in[14][(size_t)k * N1SRC + 3072 + j];
        a *= pg8::row_rs(WSP(float, WS_SSQ), (int)tok);
        WSP(float, WS_BG)[tok * 16 + j] = j < 6 ? sigmoid_f(a) : -expf(F.in[16][j - 6]) * softplus_f(a + F.in[17][j - 6]);
    }
}
DI void l1_s5_scan(Frame& F) {
    for (int wi = F.gwave; wi < 32; wi += F.gwaves) {
        const int g = wi & 15, b = wi >> 4, n = F.lane;
        const f32x2 lam = WSP(f32x2, WS_S5C)[g * 64 + n];
        f32x2 bb[16], cc[16]; float dsk[16];
#pragma unroll
        for (int c = 0; c < 16; ++c) { bb[c] = WSP(f32x2, WS_S5C + 16 * 64 * 8)[(g * 64 + n) * 16 + c]; cc[c] = (f32x2){F.in[24][(g * 16 + c) * 64 + n], F.in[25][(g * 16 + c) * 64 + n]}; dsk[c] = F.in[26][g * 16 + c]; }
        float hre = 0.f, him = 0.f;
#pragma unroll 1
        for (int t = 0; t < L; ++t) { const size_t tok = (size_t)b * L + t; const bf16_t* up = P1B + tok * N1 + 3072 + g * 16;
            float u[16]; float bre = 0.f, bim = 0.f;
#pragma unroll
            for (int c = 0; c < 16; ++c) { u[c] = bf2f(up[c]); bre += u[c] * bb[c][0]; bim += u[c] * bb[c][1]; }
            const float nre = lam[0] * hre - lam[1] * him + bre, nim = lam[0] * him + lam[1] * hre + bim; hre = nre; him = nim;
            float mine = 0.f;
#pragma unroll
            for (int c = 0; c < 16; ++c) { const float y = wave_sum(cc[c][0] * hre - cc[c][1] * him) + dsk[c] * u[c]; mine = (n == c) ? y : mine; }
            if (n < 16) YG[tok * 256 + g * 16 + n] = f2bf(gelu_tanh_f(mine));
        }
    }
}
DI void l1_level_b(Frame& F) {
    for (long idx = F.gtid; idx < (long)T * 12; idx += F.gthreads) {
        const int h = (int)(idx % 6), which = (int)((idx / 6) & 1); const size_t tok = (size_t)(idx / 12); bf16_t* p = (which ? KC : QC) + tok * 768 + h * 128; float ss = 0.f;
        for (int d = 0; d < 128; ++d) { const float x = bf2f(p[d]); ss += x * x; }
        const float r = (1.0f / sqrtf(ss + EPS)) * (which ? 1.0f : 0.08838834764831845f);
        for (int d = 0; d < 128; ++d) p[d] = f2bf(bf2f(p[d]) * r);
    }
    for (long idx = F.gtid; idx < (long)NCHT * 6; idx += F.gthreads) {
        const int h = (int)(idx % 6); const long ch = idx / 6; float run = 0.f;
        for (int l = 0; l < 64; ++l) { const size_t tok = (size_t)ch * 64 + l; run += WSP(float, WS_BG)[tok * 16 + 6 + h]; WSP(float, WS_GC)[tok * 8 + h] = run; }
    }
}
DI void l1_s5_glu(Frame& F) {
    for (long idx = F.gtid; idx < (long)T * 256; idx += F.gthreads) {
        const int c = (int)(idx & 255); const size_t tok = (size_t)(idx >> 8); const bf16_t* y = YG + tok * 256; float z = F.in[28][c];
        for (int j = 0; j < 256; ++j) z += bf2f(y[j]) * F.in[27][j * 256 + c];
        WSP(bf16_t, WS_MIX)[tok * 1024 + 768 + c] = f2bf(bf2f(y[c]) * sigmoid_f(z));
    }
}
DI void l1_level_c(Frame& F) {
    for (long idx = F.gtid; idx < (long)NCHT * 6 * 4096; idx += F.gthreads) {
        const int s = (int)(idx & 63), l = (int)((idx >> 6) & 63); const long r2 = idx >> 12; const int h = (int)(r2 % 6); const long ch = r2 / 6;
        const size_t tl = (size_t)ch * 64 + l, ts = (size_t)ch * 64 + s; float att = 0.f, low = 0.f;
        if (s <= l) { const bf16_t* q = QC + tl * 768 + h * 128; const bf16_t* kl = KC + tl * 768 + h * 128; const bf16_t* ks = KC + ts * 768 + h * 128; float qk = 0.f, kk = 0.f;
            for (int d = 0; d < 128; ++d) { const float kv = bf2f(ks[d]); qk += bf2f(q[d]) * kv; kk += bf2f(kl[d]) * kv; }
            const float dec = expf(WSP(float, WS_GC)[tl * 8 + h] - WSP(float, WS_GC)[ts * 8 + h]);
            att = qk * dec; if (s < l) low = WSP(float, WS_BG)[tl * 16 + h] * kk * dec; }
        P1B[tl * N1 + 1536 + h * 128 + s] = f2bf(att); P1B[tl * N1 + 1536 + h * 128 + 64 + s] = f2bf(low);
    }
}
DI void l1_level_d(Frame& F) {
    LAS float* x = (LAS float*)F.lds + F.tid;
    for (long idx = F.gtid; idx < (long)NCHT * 6 * 256; idx += F.gthreads) {
        const int col = (int)(idx & 255); const long r2 = idx >> 8; const int h = (int)(r2 % 6); const long ch = r2 / 6;
#pragma unroll 1
        for (int l = 0; l < 64; ++l) { const size_t tok = (size_t)ch * 64 + l; const float beta = WSP(float, WS_BG)[tok * 16 + h];
            float r = col < 128 ? bf2f(VC[tok * 768 + h * 128 + col]) * beta : bf2f(KC[tok * 768 + h * 128 + col - 128]) * beta * expf(WSP(float, WS_GC)[tok * 8 + h]);
            const bf16_t* low = P1B + tok * N1 + 1536 + h * 128 + 64;
            for (int s = 0; s < l; ++s) r -= bf2f(low[s]) * x[s * 512];
            x[l * 512] = r; }
#pragma unroll 1
        for (int l = 0; l < 64; ++l) { const size_t tok = (size_t)ch * 64 + l; P1B[tok * N1 + (col < 128 ? h * 128 + col : 768 + h * 128 + col - 128)] = f2bf(x[l * 512]); }
    }
}
DI void l1_level_e(Frame& F) {
    if (F.gtid < 1536) {
        const int e = (int)(F.gtid & 127); const int bh = (int)(F.gtid >> 7), h = bh % 6, b = bh / 6;
        LAS float* vn = (LAS float*)F.lds + F.tid;
        float S[128];
#pragma unroll
        for (int d = 0; d < 128; ++d) S[d] = 0.f;
#pragma unroll 1
        for (int c = 0; c < L / 64; ++c) {
            const size_t tok0 = (size_t)b * L + c * 64; const float gl = WSP(float, WS_GC)[(tok0 + 63) * 8 + h];
#pragma unroll 1
            for (int l = 0; l < 64; ++l) { const size_t tok = tok0 + l; const u32x4* w = (const u32x4*)(P1B + tok * N1 + 768 + h * 128); float a = bf2f(P1B[tok * N1 + h * 128 + e]);
#pragma unroll
                for (int d8 = 0; d8 < 16; ++d8) { const u32x4 ww = w[d8];
#pragma unroll
                    for (int j = 0; j < 4; ++j) { a -= __uint_as_float(ww[j] << 16) * S[d8 * 8 + 2 * j]; a -= __uint_as_float(ww[j] & 0xffff0000u) * S[d8 * 8 + 2 * j + 1]; } }
                vn[l * 512] = a; }
#pragma unroll 1
            for (int l = 0; l < 64; ++l) { const size_t tok = tok0 + l; const u32x4* q = (const u32x4*)(QC + tok * 768 + h * 128); float a = 0.f;
#pragma unroll
                for (int d8 = 0; d8 < 16; ++d8) { const u32x4 ww = q[d8];
#pragma unroll
                    for (int j = 0; j < 4; ++j) { a += __uint_as_float(ww[j] << 16) * S[d8 * 8 + 2 * j]; a += __uint_as_float(ww[j] & 0xffff0000u) * S[d8 * 8 + 2 * j + 1]; } }
                a *= expf(WSP(float, WS_GC)[tok * 8 + h]);
                const bf16_t* att = P1B + tok * N1 + 1536 + h * 128;
                for (int s = 0; s <= l; ++s) a += bf2f(att[s]) * vn[s * 512];
                P1B[tok * N1 + h * 128 + e] = f2bf(a); }
            const float cd = expf(gl);
#pragma unroll
            for (int d = 0; d < 128; ++d) S[d] *= cd;
#pragma unroll 1
            for (int l = 0; l < 64; ++l) { const size_t tok = tok0 + l; const u32x4* k = (const u32x4*)(KC + tok * 768 + h * 128); const float vv = vn[l * 512] * expf(gl - WSP(float, WS_GC)[tok * 8 + h]);
#pragma unroll
                for (int d8 = 0; d8 < 16; ++d8) { const u32x4 ww = k[d8];
#pragma unroll
                    for (int j = 0; j < 4; ++j) { S[d8 * 8 + 2 * j] += __uint_as_float(ww[j] << 16) * vv; S[d8 * 8 + 2 * j + 1] += __uint_as_float(ww[j] & 0xffff0000u) * vv; } } }
        }
    }
}
DI void l1_level_f(Frame& F) {
    for (long idx = F.gtid; idx < (long)T * 6; idx += F.gthreads) {
        const int h = (int)(idx % 6); const size_t tok = (size_t)(idx / 6); const bf16_t* o = P1B + tok * N1 + h * 128; float ss = 0.f;
        for (int e = 0; e < 128; ++e) { const float v = bf2f(o[e]); ss += v * v; }
        const float r = 1.0f / sqrtf(ss * (1.0f / 128.0f) + EPS);
        for (int e = 0; e < 128; ++e) WSP(bf16_t, WS_MIX)[tok * 1024 + h * 128 + e] = f2bf(bf2f(o[e]) * r * F.in[18][e] * silu_f(bf2f(P1B[tok * N1 + 2304 + h * 128 + e])));
    }
}

constexpr int GDN_UNITS = NCHT * 6;
constexpr size_t WS_G_FLAG = WS_CTL + 16384;
#ifndef CPU_EMU
DI void flag_publish(unsigned* p) { __hip_atomic_store(p, 1u, __ATOMIC_RELAXED, __HIP_MEMORY_SCOPE_AGENT); }
DI void flag_wait(unsigned* p) { unsigned sp = 0; while (__hip_atomic_load(p, __ATOMIC_RELAXED, __HIP_MEMORY_SCOPE_AGENT) == 0u) { __builtin_amdgcn_s_sleep(8); if (++sp > (1u << 24)) break; } }
DI void acquire_agent() { __builtin_amdgcn_fence(__ATOMIC_ACQUIRE, "agent"); asm volatile("s_waitcnt vmcnt(0)" ::: "memory"); }
#else
DI void flag_publish(unsigned* p) { *(volatile unsigned*)p = 1u; }
DI void flag_wait(unsigned* p) { while (*(volatile unsigned*)p == 0u) emu::yield(); }
DI void acquire_agent() {}
#endif
constexpr size_t WS_G_WF = WS_XN;
constexpr size_t WS_G_QGF = WS_G_WF + (size_t)GDN_UNITS * 16384;
constexpr size_t WS_G_ATF = WS_G_QGF + (size_t)GDN_UNITS * 16384;
constexpr size_t WS_G_KTF = WS_PROJ + (size_t)T * N1 * 2;
constexpr size_t WS_G_UP = WS_G_KTF + (size_t)GDN_UNITS * 16384;
constexpr size_t WS_G_CD = WS_LAC;
static_assert(WS_G_ATF + (size_t)GDN_UNITS * 8192 <= WS_PROJ && WS_G_UP + (size_t)GDN_UNITS * 16384 <= WS_END && (size_t)GDN_UNITS * 4 <= (size_t)T * 32 && (size_t)T * 512 <= WS_W_IN1 - WS_W_IN0, "gdn workspace");

DI void gdn_g1(Frame& F, int first, int stride) {
    LAS unsigned char* lds = F.lds;
    LAS bf16_t* QS = (LAS bf16_t*)(lds);
    LAS bf16_t* KS = (LAS bf16_t*)(lds + 17408);
    LAS bf16_t* KTt = (LAS bf16_t*)(lds + 34816);
    LAS bf16_t* VTt = (LAS bf16_t*)(lds + 53248);
    LAS float* LM = (LAS float*)(lds + 71680);
    LAS bf16_t* USm = (LAS bf16_t*)(lds + 71680);
    LAS bf16_t* TU = (LAS bf16_t*)(lds + 89088);
    LAS bf16_t* TW = (LAS bf16_t*)(lds + 98304);
    LAS bf16_t* AT = (LAS bf16_t*)(lds + 107520);
    LAS bf16_t* WSm = (LAS bf16_t*)(lds + 116736);
    LAS float* TM = (LAS float*)(lds + 116736);
    LAS float* SM = (LAS float*)(lds + 134144);
    LAS float* PS = (LAS float*)(lds + 135168);
    const int w = F.wave;
    const bf16_t* P1 = WSP(bf16_t, WS_PROJ);
    for (int ui = first; ui < GDN_UNITS; ui += stride) {
        const int u = (((ui % 12) / 6) * (L / 64) + ui / 12) * 6 + (ui % 12) % 6;
        int tid = F.tid; OPAQUE_V(tid);
        const int lane = tid & 63, fr = lane & 15, fq = lane >> 4;
        const int ch = u / 6, h = u % 6; const long tok0 = (long)ch * 64; const int t0 = (int)(tok0 % L);
        if (tid < 384) {
            const int oc = tid % 48, rg = tid / 48, c0 = 8 * oc, which = c0 >> 7, d = c0 & 127, gcol = which * 768 + h * 128 + d, l0 = 8 * rg; u32x4 y[8];
            conv_oct(P1 + (size_t)(tok0 + l0 - 3) * N1 + gcol, N1, t0 + l0 - 3, F.in[15] + gcol, 2304, nullptr, y);
            if (which == 0) {
#pragma unroll
                for (int r = 0; r < 8; ++r) *(LAS u32x4*)(QS + (l0 + r) * 136 + d) = y[r];
            } else if (which == 1) {
#pragma unroll
                for (int r = 0; r < 8; ++r) *(LAS u32x4*)(KS + (l0 + r) * 136 + d) = y[r];
#pragma unroll
                for (int c = 0; c < 8; ++c) *(LAS u32x4*)(KTt + (d + c) * 72 + ((rg ^ (oc & 7)) << 3)) = pack_col(y, c);
            } else {
#pragma unroll
                for (int c = 0; c < 8; ++c) *(LAS u32x4*)(VTt + (d + c) * 72 + ((rg ^ (oc & 7)) << 3)) = pack_col(y, c);
            }
        } else if (tid < 448) {
            const int l = tid - 384; const float* bg = WSP(float, WS_BG) + (size_t)(tok0 + l) * 16; float g = -expf(F.in[16][h]) * softplus_f(bg[6 + h] + F.in[17][h]);
#pragma unroll
            for (int o = 1; o < 64; o <<= 1) { const float t = __shfl_up(g, o); if (l >= o) g += t; }
            SM[l] = g; SM[64 + l] = sigmoid_f(bg[h]);
        }
        __syncthreads();
        const int ti = w >> 1, jp = w & 1;
        f32x4 kk0 = {0.f, 0.f, 0.f, 0.f}, kk1 = kk0, qk0 = kk0, qk1 = kk0, qq = kk0;
#pragma unroll
        for (int kx = 0; kx < 4; ++kx) {
            const bf16x8 ak = ldsfrag(KS, 16 * ti + fr, 32 * kx + 8 * fq, 136), aq = ldsfrag(QS, 16 * ti + fr, 32 * kx + 8 * fq, 136);
            const bf16x8 b0 = ldsfrag(KS, 32 * jp + fr, 32 * kx + 8 * fq, 136), b1 = ldsfrag(KS, 32 * jp + 16 + fr, 32 * kx + 8 * fq, 136);
            kk0 = __builtin_amdgcn_mfma_f32_16x16x32_bf16(ak, b0, kk0, 0, 0, 0); kk1 = __builtin_amdgcn_mfma_f32_16x16x32_bf16(ak, b1, kk1, 0, 0, 0);
            qk0 = __builtin_amdgcn_mfma_f32_16x16x32_bf16(aq, b0, qk0, 0, 0, 0); qk1 = __builtin_amdgcn_mfma_f32_16x16x32_bf16(aq, b1, qk1, 0, 0, 0);
            if (jp == 0) qq = __builtin_amdgcn_mfma_f32_16x16x32_bf16(aq, aq, qq, 0, 0, 0);
        }
        if ((fr >> 2) == fq) {
            if (jp == (ti >> 1)) SM[128 + 16 * ti + fr] = sel4((ti & 1) ? kk1 : kk0, fr & 3);
            if (jp == 0) SM[192 + 16 * ti + fr] = sel4(qq, fr & 3);
        }
        __syncthreads();
#pragma unroll
        for (int jj = 0; jj < 2; ++jj) { const int s = 32 * jp + 16 * jj + fr; const float rks = __builtin_amdgcn_rsqf(SM[128 + s] + EPS), gs = SM[s]; const f32x4 kv = jj ? kk1 : kk0, qv = jj ? qk1 : qk0;
#pragma unroll
            for (int r = 0; r < 4; ++r) { const int l = 16 * ti + 4 * fq + r; const float dec = s <= l ? __expf(SM[l] - gs) : 0.f;
                const float rkl = __builtin_amdgcn_rsqf(SM[128 + l] + EPS), rql = 0.08838834764831845f * __builtin_amdgcn_rsqf(SM[192 + l] + EPS);
                LM[l * 68 + s] = s < l ? SM[64 + l] * kv[r] * rkl * rks * dec : 0.f;
                AT[l * 72 + s] = f2bf(qv[r] * rql * rks * dec); } }
        __syncthreads();
        if (w == 0) {
            const int blk = lane >> 4, j = lane & 15; const LAS float* Lb = LM + (16 * blk) * 68 + 16 * blk; float x[16];
#pragma unroll
            for (int r = 0; r < 16; ++r) { float a = (r == j) ? 1.f : 0.f;
#pragma unroll
                for (int s2 = 0; s2 < r; ++s2) a -= Lb[r * 68 + s2] * x[s2];
                x[r] = a; }
#pragma unroll
            for (int r = 0; r < 16; ++r) TM[(16 * blk + r) * 68 + 16 * blk + j] = x[r];
        }
        __syncthreads();
#pragma unroll
        for (int lev = 1; lev <= 3; ++lev) {
            if (w < 4 - lev) { const int bi = w + lev, bj = w; f32x4 acc = {0.f, 0.f, 0.f, 0.f};
                for (int k = bj; k < bi; ++k)
#pragma unroll
                    for (int kx = 0; kx < 4; ++kx) acc = __builtin_amdgcn_mfma_f32_16x16x4f32(LM[(16 * bi + fr) * 68 + 16 * k + 4 * kx + fq], TM[(16 * k + 4 * kx + fq) * 68 + 16 * bj + fr], acc, 0, 0, 0);
                LAS float* sc = PS + w * 320;
#pragma unroll
                for (int r = 0; r < 4; ++r) sc[(4 * fq + r) * 20 + fr] = acc[r];
                WAIT_L(0);
                f32x4 t2 = {0.f, 0.f, 0.f, 0.f};
#pragma unroll
                for (int kx = 0; kx < 4; ++kx) t2 = __builtin_amdgcn_mfma_f32_16x16x4f32(TM[(16 * bi + fr) * 68 + 16 * bi + 4 * kx + fq], sc[(4 * kx + fq) * 20 + fr], t2, 0, 0, 0);
#pragma unroll
                for (int r = 0; r < 4; ++r) TM[(16 * bi + 4 * fq + r) * 68 + 16 * bj + fr] = -t2[r];
            }
            __syncthreads();
        }
        {
            for (int idx = tid; idx < 4096; idx += NTHREADS) { const int l = idx >> 6, s2 = idx & 63; const float t = (s2 >> 4) <= (l >> 4) ? TM[l * 68 + s2] : 0.f; const float bj = SM[64 + s2];
                TU[l * 72 + s2] = f2bf(t * bj); TW[l * 72 + s2] = f2bf(t * bj * __expf(SM[s2]) * __builtin_amdgcn_rsqf(SM[128 + s2] + EPS)); }
            if (tid == 0) store4_wt(WSP(float, WS_G_CD) + u, expf(SM[63]));
            const float glast = SM[63];
            for (int it = tid; it < 2560; it += NTHREADS) {
                if (it < 1024) { const int f = it >> 6, ln = it & 63, l = 16 * (f >> 2) + (ln & 15), d0 = 32 * (f & 3) + 4 * (ln >> 4);
                    const float sc = 0.08838834764831845f * __builtin_amdgcn_rsqf(SM[192 + l] + EPS) * __expf(SM[l]);
                    const u32x2 a = *(const LAS u32x2*)(QS + l * 136 + d0), b = *(const LAS u32x2*)(QS + l * 136 + d0 + 16);
                    u32x4 o; o.x = pk2(__uint_as_float(a.x << 16) * sc, __uint_as_float(a.x & 0xffff0000u) * sc); o.y = pk2(__uint_as_float(a.y << 16) * sc, __uint_as_float(a.y & 0xffff0000u) * sc);
                    o.z = pk2(__uint_as_float(b.x << 16) * sc, __uint_as_float(b.x & 0xffff0000u) * sc); o.w = pk2(__uint_as_float(b.y << 16) * sc, __uint_as_float(b.y & 0xffff0000u) * sc);
                    store16_wt(F.ws + WS_G_QGF + (size_t)u * 16384 + it * 16, o);
                } else if (it < 2048) { const int i2 = it - 1024, f = i2 >> 6, ln = i2 & 63, d = 16 * (f >> 1) + (ln & 15), k0 = 32 * (f & 1) + 4 * (ln >> 4);
                    float sc[8];
#pragma unroll
                    for (int j = 0; j < 8; ++j) { const int tk = k0 + 16 * (j >> 2) + (j & 3); sc[j] = __expf(glast - SM[tk]) * __builtin_amdgcn_rsqf(SM[128 + tk] + EPS); }
                    const int swk = (d >> 3) & 7; const u32x2 a = *(const LAS u32x2*)(KTt + d * 72 + ((((k0 >> 3) ^ swk) << 3) | (k0 & 7))), b = *(const LAS u32x2*)(KTt + d * 72 + (((((k0 + 16) >> 3) ^ swk) << 3) | (k0 & 7)));
                    u32x4 o; o.x = pk2(__uint_as_float(a.x << 16) * sc[0], __uint_as_float(a.x & 0xffff0000u) * sc[1]); o.y = pk2(__uint_as_float(a.y << 16) * sc[2], __uint_as_float(a.y & 0xffff0000u) * sc[3]);
                    o.z = pk2(__uint_as_float(b.x << 16) * sc[4], __uint_as_float(b.x & 0xffff0000u) * sc[5]); o.w = pk2(__uint_as_float(b.y << 16) * sc[6], __uint_as_float(b.y & 0xffff0000u) * sc[7]);
                    store16_wt(F.ws + WS_G_KTF + (size_t)u * 16384 + i2 * 16, o);
                } else { const int i2 = it - 2048, f = i2 >> 6, ln = i2 & 63, l = 16 * (f >> 1) + (ln & 15), k0 = 32 * (f & 1) + 4 * (ln >> 4);
                    const u32x2 a = *(const LAS u32x2*)(AT + l * 72 + k0), b = *(const LAS u32x2*)(AT + l * 72 + k0 + 16);
                    u32x4 o; o.x = a.x; o.y = a.y; o.z = b.x; o.w = b.y;
                    store16_wt(F.ws + WS_G_ATF + (size_t)u * 8192 + i2 * 16, o); }
            }
        }
        __syncthreads();
        {
            f32x4 au[4], aw[4];
#pragma unroll
            for (int n = 0; n < 4; ++n) { au[n] = (f32x4){0.f, 0.f, 0.f, 0.f}; aw[n] = au[n]; }
#pragma unroll
            for (int k2 = 0; k2 < 2; ++k2) { const bf16x8 fu = ldsfrag(TU, 16 * ti + fr, 32 * k2 + 8 * fq, 72), fw = ldsfrag(TW, 16 * ti + fr, 32 * k2 + 8 * fq, 72);
#pragma unroll
                for (int n = 0; n < 4; ++n) { const int col = 16 * (4 * jp + n) + fr, cs = 8 * ((4 * k2 + fq) ^ ((2 * n + (fr >> 3)) & 7));
                    au[n] = __builtin_amdgcn_mfma_f32_16x16x32_bf16(fu, ldsfrag(VTt, col, cs, 72), au[n], 0, 0, 0);
                    aw[n] = __builtin_amdgcn_mfma_f32_16x16x32_bf16(fw, ldsfrag(KTt, col, cs, 72), aw[n], 0, 0, 0); } }
#pragma unroll
            for (int n = 0; n < 4; ++n)
#pragma unroll
                for (int r = 0; r < 4; ++r) { const int l = 16 * ti + 4 * fq + r, col = 16 * (4 * jp + n) + fr; USm[l * 136 + col] = f2bf(au[n][r]); WSm[l * 136 + col] = f2bf(aw[n][r]); }
        }
        __syncthreads();
        for (int it = tid; it < 1536; it += NTHREADS) {
            if (it < 1024) { const int f = it >> 6, ln = it & 63, l = 16 * (f >> 2) + (ln & 15), d0 = 32 * (f & 3) + 4 * (ln >> 4);
                const u32x2 a = *(const LAS u32x2*)(WSm + l * 136 + d0), b = *(const LAS u32x2*)(WSm + l * 136 + d0 + 16);
                u32x4 o; o.x = a.x; o.y = a.y; o.z = b.x; o.w = b.y; store16_wt(F.ws + WS_G_WF + (size_t)u * 16384 + it * 16, o);
            } else { const int i2 = it - 1024, sl = i2 >> 6, ln = i2 & 63, e = 16 * sl + (ln & 15); unsigned o[8];
#pragma unroll
                for (int q2 = 0; q2 < 8; ++q2) { const int i0 = 2 * q2, l = 16 * (i0 >> 2) + 4 * (ln >> 4) + (i0 & 3); o[q2] = (unsigned)USm[l * 136 + e] | ((unsigned)USm[(l + 1) * 136 + e] << 16); }
                unsigned char* dst = F.ws + WS_G_UP + (size_t)u * 16384 + i2 * 32; store16_wt(dst, (u32x4){o[0], o[1], o[2], o[3]}); store16_wt(dst + 16, (u32x4){o[4], o[5], o[6], o[7]}); }
        }
        WAIT_V(0); __syncthreads();
        if (F.tid == 0) flag_publish(WSP(unsigned, WS_G_FLAG) + u);
    }
}

#ifndef G2_PROBE_MODE
#define G2_PROBE_MODE 0
#endif
DI void gdn_g2(Frame& F, const int mode = 0) {
    constexpr int NC = L / 64; const int lane = F.lane; LAS unsigned char* lds = F.lds;
    for (int bid = blockIdx.x; bid < 64; bid += F.G) {
    const int bh = 8 * (bid >> 5) + (bid & 7), quarter = (bid >> 3) & 3, b = bh / 6, h = bh % 6; if (bh >= 12) continue;
    if (F.wave >= 2) {
        const int lw = F.wave - 2; const size_t ub = ((size_t)b * NC) * 6 + h;
        int ready = 0;
        auto ld = [&](int c, u32x4 (&v)[10], float& cdv) { if (c < NC) {
            if (c >= ready) { const int hi = c + 16 < NC ? c + 16 : NC; for (int k = ready; k < hi; ++k) flag_wait(WSP(unsigned, WS_G_FLAG) + ub + (size_t)6 * k); acquire_agent(); ready = hi; }
            const size_t u = ub + (size_t)6 * ((mode == 1 || mode == 4) ? 0 : c);
            const unsigned char* s0 = F.ws + WS_G_WF + u * 16384; const unsigned char* s1 = F.ws + WS_G_QGF + u * 16384; const unsigned char* s2 = F.ws + WS_G_KTF + u * 16384; const unsigned char* s3 = F.ws + WS_G_ATF + u * 8192;
            const unsigned char* s4 = F.ws + WS_G_UP + u * 16384 + (size_t)quarter * 4096;
#pragma unroll
            for (int k = 0; k < 10; ++k) { const int f = lw + 6 * k; const unsigned char* src = f < 16 ? s0 + f * 1024 : f < 32 ? s1 + (f - 16) * 1024 : f < 48 ? s2 + (f - 32) * 1024 : f < 56 ? s3 + (f - 48) * 1024 : s4 + (f - 56) * 1024;
                v[k] = *(const u32x4*)(src + lane * 16); }
            cdv = WSP(float, WS_G_CD)[u]; } };
        auto st = [&](int c, const u32x4 (&v)[10], float cdv) { if (c < NC) { LAS unsigned char* buf = lds + (c & 1) * 65536;
#pragma unroll
            for (int k = 0; k < 10; ++k) { const int f = lw + 6 * k; *(LAS u32x4*)(buf + f * 1024 + lane * 16) = v[k]; }
            if (lw == 0 && lane == 0) ((LAS float*)(lds + 131072))[c & 1] = cdv; } };
        u32x4 va[10], vb[10], vc[10]; float ca = 0.f, cb = 0.f, cc = 0.f;
        ld(0, va, ca); st(0, va, ca); ld(1, va, ca); ld(2, vb, cb); ld(3, vc, cc);
        WAIT_L(0); __builtin_amdgcn_s_barrier();
#pragma unroll 1
        for (int c = 0; c < NC; c += 3) {
            st(c + 1, va, ca); ld(c + 4, va, ca); WAIT_L(0); __builtin_amdgcn_s_barrier();
            if (c + 1 < NC) { st(c + 2, vb, cb); ld(c + 5, vb, cb); WAIT_L(0); __builtin_amdgcn_s_barrier(); }
            if (c + 2 < NC) { st(c + 3, vc, cc); ld(c + 6, vc, cc); WAIT_L(0); __builtin_amdgcn_s_barrier(); }
        }
    } else {
        const int sl = quarter * 2 + F.wave;
        f32x4 S[8]; bf16x8 Sb[4];
#pragma unroll
        for (int i = 0; i < 8; ++i) S[i] = (f32x4){0.f, 0.f, 0.f, 0.f};
#pragma unroll
        for (int i = 0; i < 4; ++i) Sb[i] = pack8(S[0], S[0]);
        __builtin_amdgcn_s_barrier();
#pragma unroll 1
        for (int c = 0; c < NC; ++c) {
            if (mode == 2 || mode == 4) { __builtin_amdgcn_s_barrier(); continue; }
            const LAS unsigned char* bufb = lds + (c & 1) * 65536; const LAS unsigned char* buf = bufb + lane * 16;
            const LAS u32x4* ul = (const LAS u32x4*)(bufb + 57344 + F.wave * 2048 + lane * 32); const u32x4 u0 = ul[0], u1 = ul[1]; const float cd = ((const LAS float*)(lds + 131072))[c & 1];
#define G2_LD8(dst, off0, stride, off1) do { _Pragma("unroll") for (int _j = 0; _j < 4; ++_j) { dst[_j] = *(const LAS bf16x8*)(buf + (off0) + _j * (stride)); dst[4 + _j] = *(const LAS bf16x8*)(buf + (off1) + _j * (stride)); } } while (0)
#define G2_SCHED __builtin_amdgcn_sched_barrier(0)
            f32x4 ws[4], qs[4]; bf16x8 fa[8], fb[8];
#pragma unroll
            for (int i = 0; i < 4; ++i) { ws[i] = (f32x4){0.f, 0.f, 0.f, 0.f}; qs[i] = ws[i]; }
            G2_LD8(fa, 0, 4096, 16384);
            G2_LD8(fb, 1024, 4096, 16384 + 1024); WAIT_L(8); G2_SCHED;
#pragma unroll
            for (int i = 0; i < 4; ++i) { ws[i] = __builtin_amdgcn_mfma_f32_16x16x32_bf16(fa[i], Sb[0], ws[i], 0, 0, 0); qs[i] = __builtin_amdgcn_mfma_f32_16x16x32_bf16(fa[4 + i], Sb[0], qs[i], 0, 0, 0); }
            G2_SCHED; G2_LD8(fa, 2048, 4096, 16384 + 2048); WAIT_L(8); G2_SCHED;
#pragma unroll
            for (int i = 0; i < 4; ++i) { ws[i] = __builtin_amdgcn_mfma_f32_16x16x32_bf16(fb[i], Sb[1], ws[i], 0, 0, 0); qs[i] = __builtin_amdgcn_mfma_f32_16x16x32_bf16(fb[4 + i], Sb[1], qs[i], 0, 0, 0); }
            G2_SCHED; G2_LD8(fb, 3072, 4096, 16384 + 3072); WAIT_L(8); G2_SCHED;
#pragma unroll
            for (int i = 0; i < 4; ++i) { ws[i] = __builtin_amdgcn_mfma_f32_16x16x32_bf16(fa[i], Sb[2], ws[i], 0, 0, 0); qs[i] = __builtin_amdgcn_mfma_f32_16x16x32_bf16(fa[4 + i], Sb[2], qs[i], 0, 0, 0); }
            G2_SCHED; G2_LD8(fa, 49152, 2048, 49152 + 1024); WAIT_L(8); G2_SCHED;
#pragma unroll
            for (int i = 0; i < 4; ++i) { ws[i] = __builtin_amdgcn_mfma_f32_16x16x32_bf16(fb[i], Sb[3], ws[i], 0, 0, 0); qs[i] = __builtin_amdgcn_mfma_f32_16x16x32_bf16(fb[4 + i], Sb[3], qs[i], 0, 0, 0); }
            G2_SCHED;
            const unsigned uw[8] = {u0.x, u0.y, u0.z, u0.w, u1.x, u1.y, u1.z, u1.w};
            f32x4 vn[4];
#pragma unroll
            for (int i = 0; i < 4; ++i) { vn[i][0] = __uint_as_float(uw[2 * i] << 16) - ws[i][0]; vn[i][1] = __uint_as_float(uw[2 * i] & 0xffff0000u) - ws[i][1];
                vn[i][2] = __uint_as_float(uw[2 * i + 1] << 16) - ws[i][2]; vn[i][3] = __uint_as_float(uw[2 * i + 1] & 0xffff0000u) - ws[i][3]; }
            const bf16x8 vb0 = pack8(vn[0], vn[1]), vb1 = pack8(vn[2], vn[3]);
            G2_SCHED; G2_LD8(fb, 32768, 2048, 32768 + 1024); WAIT_L(8); G2_SCHED;
#pragma unroll
            for (int i = 0; i < 4; ++i) { qs[i] = __builtin_amdgcn_mfma_f32_16x16x32_bf16(fa[i], vb0, qs[i], 0, 0, 0); qs[i] = __builtin_amdgcn_mfma_f32_16x16x32_bf16(fa[4 + i], vb1, qs[i], 0, 0, 0); }
            G2_SCHED; G2_LD8(fa, 32768 + 8192, 2048, 32768 + 8192 + 1024); WAIT_L(8); G2_SCHED;
#pragma unroll
            for (int dt = 0; dt < 4; ++dt) { S[dt] = S[dt] * cd; S[dt] = __builtin_amdgcn_mfma_f32_16x16x32_bf16(fb[dt], vb0, S[dt], 0, 0, 0); S[dt] = __builtin_amdgcn_mfma_f32_16x16x32_bf16(fb[4 + dt], vb1, S[dt], 0, 0, 0); }
            G2_SCHED; WAIT_L(0); G2_SCHED;
#pragma unroll
            for (int dt = 0; dt < 4; ++dt) { S[4 + dt] = S[4 + dt] * cd; S[4 + dt] = __builtin_amdgcn_mfma_f32_16x16x32_bf16(fa[dt], vb0, S[4 + dt], 0, 0, 0); S[4 + dt] = __builtin_amdgcn_mfma_f32_16x16x32_bf16(fa[4 + dt], vb1, S[4 + dt], 0, 0, 0); }
            G2_SCHED;
#undef G2_LD8
#undef G2_SCHED
            if (mode == 0) { const int rec = sl * 64 + lane;
                u32x4 o0, o1; o0.x = cvt_pk_bf16(qs[0][0], qs[0][1]); o0.y = cvt_pk_bf16(qs[0][2], qs[0][3]); o0.z = cvt_pk_bf16(qs[1][0], qs[1][1]); o0.w = cvt_pk_bf16(qs[1][2], qs[1][3]);
                o1.x = cvt_pk_bf16(qs[2][0], qs[2][1]); o1.y = cvt_pk_bf16(qs[2][2], qs[2][3]); o1.z = cvt_pk_bf16(qs[3][0], qs[3][1]); o1.w = cvt_pk_bf16(qs[3][2], qs[3][3]);
                u32x4* op = (u32x4*)(WSP(bf16_t, WS_PROJ) + ((size_t)b * L + (size_t)c * 64 + (rec >> 3)) * N1 + h * 128 + (rec & 7) * 16); op[0] = o0; op[1] = o1; }
            else { float keep = qs[0][0] + qs[1][1] + qs[2][2] + qs[3][3]; asm volatile("" :: "v"(keep)); }
#pragma unroll
            for (int kx = 0; kx < 4; ++kx) Sb[kx] = pack8(S[2 * kx], S[2 * kx + 1]);
            __builtin_amdgcn_s_barrier();
        }
    }
    }
}
DI void gdn_g3(Frame& F) {
    const bf16_t* P1 = WSP(bf16_t, WS_PROJ); bf16_t* mix = WSP(bf16_t, WS_MIX); const int lane = F.lane, e = 2 * lane; const float nw0 = F.in[18][e], nw1 = F.in[18][e + 1];
    for (long trip = F.gwave; trip < (long)T * 6 / 8; trip += F.gwaves) {
        const int ah = (int)(trip & 1), j = (int)((trip >> 1) & 3); const long ch6 = trip >> 3; const int h = (int)(ch6 % 6); const size_t tokb = (size_t)(ch6 / 6) * 64;
        const int rec0 = (e >> 4) * 64 + (e & 15) + 16 * j; const bf16_t* orow = P1 + (tokb + (rec0 >> 3)) * N1 + h * 128 + (rec0 & 7) * 16 + 8 * ah;
        const u32x4 ra = *(const u32x4*)orow, rb = *(const u32x4*)(orow + 16); unsigned zz[8];
#pragma unroll
        for (int k = 0; k < 8; ++k) { const size_t tok = tokb + 16 * (2 * ah + (k >> 2)) + 4 * j + (k & 3); zz[k] = *(const unsigned*)(P1 + tok * N1 + 2304 + h * 128 + e); }
#pragma unroll
        for (int k = 0; k < 8; ++k) { const size_t tok = tokb + 16 * (2 * ah + (k >> 2)) + 4 * j + (k & 3); const float o0 = u4elem(ra, k), o1 = u4elem(rb, k);
            const float r = __builtin_amdgcn_rsqf(wave_sum(o0 * o0 + o1 * o1) * (1.0f / 128.0f) + EPS);
            *(unsigned*)(mix + tok * 1024 + h * 128 + e) = pk2(o0 * r * nw0 * silu_f(bflo(zz[k])), o1 * r * nw1 * silu_f(bfhi(zz[k]))); }
    }
}

DI void s5_glu_gate(Frame& F) {
    pg8::StaticOrder S; S.init(T, 256, F.G, (int)blockIdx.x); pg8::Unit u; const bf16_t* yg = WSP(bf16_t, WS_YG); bf16_t* mix = WSP(bf16_t, WS_MIX);
    WAIT_V(0); __syncthreads();
    for (int i = 0; S.next(i, u); ++i)
        for (int it = F.tid; it < 256 * 32; it += NTHREADS) { const size_t row = (size_t)u.pm * 256 + (it >> 5); const int c = (it & 31) * 8;
            const u32x4 y = *(const u32x4*)(yg + row * 256 + c); u32x4* zp = (u32x4*)(mix + row * 1024 + 768 + c); const u32x4 z = *zp; u32x4 o;
            o.x = pk2(__uint_as_float(y.x << 16) * sigmoid_f(__uint_as_float(z.x << 16)), __uint_as_float(y.x & 0xffff0000u) * sigmoid_f(__uint_as_float(z.x & 0xffff0000u)));
            o.y = pk2(__uint_as_float(y.y << 16) * sigmoid_f(__uint_as_float(z.y << 16)), __uint_as_float(y.y & 0xffff0000u) * sigmoid_f(__uint_as_float(z.y & 0xffff0000u)));
            o.z = pk2(__uint_as_float(y.z << 16) * sigmoid_f(__uint_as_float(z.z << 16)), __uint_as_float(y.z & 0xffff0000u) * sigmoid_f(__uint_as_float(z.z & 0xffff0000u)));
            o.w = pk2(__uint_as_float(y.w << 16) * sigmoid_f(__uint_as_float(z.w << 16)), __uint_as_float(y.w & 0xffff0000u) * sigmoid_f(__uint_as_float(z.w & 0xffff0000u)));
            *zp = o; }
}

DI void s5_state_scan(Frame& F) {
    constexpr int NC16 = L / 16, NSEG = NC16 >= 32 ? 32 : NC16, SEGLEN = NC16 / NSEG; static_assert(SEGLEN >= 1 && (SEGLEN & (SEGLEN - 1)) == 0, "S5 scan segments");
    const bf16_t* HL = WSP(bf16_t, WS_S5_HL); bf16_t* HP = WSP(bf16_t, WS_S5_HP); LAS f32x2* E = (LAS f32x2*)F.lds;
    const int tr = F.tid & 15, seg = F.tid >> 4;
    for (int blk = blockIdx.x; blk < 128; blk += F.G) {
        const int gt = blk * 16 + tr, n = gt & 63, g = (gt >> 6) & 15, b = gt >> 10; double lre, lim, fre, fim; s5_lam(F.in, g, n, lre, lim, fre, fim);
#pragma unroll
        for (int k = 0; k < 4; ++k) { const double t = lre * lre - lim * lim; lim = 2.0 * lre * lim; lre = t; }
        const float pr = (float)lre, pi = (float)lim;
        for (int k = 1; k < SEGLEN; k <<= 1) { const double t = lre * lre - lim * lim; lim = 2.0 * lre * lim; lre = t; }
        const float sr = (float)lre, si = (float)lim;
        const int sg = seg < NSEG ? seg : 0; const size_t base = ((size_t)g * (T / 16) + (size_t)b * NC16 + (size_t)sg * SEGLEN) * 128 + n;
        float lr[SEGLEN], li[SEGLEN];
#pragma unroll
        for (int k = 0; k < SEGLEN; ++k) { lr[k] = bf2f(HL[base + (size_t)k * 128]); li[k] = bf2f(HL[base + (size_t)k * 128 + 64]); }
        float hre = 0.f, him = 0.f;
#pragma unroll
        for (int k = 0; k < SEGLEN; ++k) { const float t = pr * hre - pi * him + lr[k], u2 = pr * him + pi * hre + li[k]; lr[k] = hre; li[k] = him; hre = t; him = u2; }
        E[tr * 32 + seg] = (f32x2){hre, him};
        __syncthreads();
        float cre = 0.f, cim = 0.f;
        for (int j = 0; j < (seg < NSEG ? seg : 0); ++j) { const f32x2 e = E[tr * 32 + j]; const float t = sr * cre - si * cim + e[0]; cim = sr * cim + si * cre + e[1]; cre = t; }
#pragma unroll
        for (int k = 0; k < SEGLEN; ++k) { if (seg < NSEG) { HP[base + (size_t)k * 128] = f2bf(lr[k] + cre); HP[base + (size_t)k * 128 + 64] = f2bf(li[k] + cim); } const float t = pr * cre - pi * cim; cim = pr * cim + pi * cre; cre = t; }
        __syncthreads();
    }
}
DI void final_norm_load(Frame& F, int batch, u32x4 (&rows)[16][2]) {
    const bf16_t* xr = XRES;
#pragma unroll
    for (int k = 0; k < 16; ++k) { const long m = (long)F.gwave + (long)(batch * 16 + k) * F.gwaves; rows[k][0] = (u32x4){0u, 0u, 0u, 0u}; rows[k][1] = rows[k][0];
        if (m < T) { const u32x4* p = (const u32x4*)(xr + (size_t)m * D) + F.lane; rows[k][0] = p[0]; rows[k][1] = p[64]; } }
}
DI void final_norm_store(Frame& F, int batch, const u32x4 (&rows)[16][2]) {
    const f32x4* wr = (const f32x4*)F.in[33]; f32x4 wv[4];
#pragma unroll
    for (int j = 0; j < 2; ++j) { wv[2 * j] = wr[128 * j + 2 * F.lane]; wv[2 * j + 1] = wr[128 * j + 2 * F.lane + 1]; }
#pragma unroll
    for (int k = 0; k < 16; ++k) { const long m = (long)F.gwave + (long)(batch * 16 + k) * F.gwaves; f32x4 v[4]; float s = 0.f;
#pragma unroll
        for (int j = 0; j < 2; ++j) { const u32x4 b = rows[k][j]; v[2 * j] = (f32x4){bflo(b.x), bfhi(b.x), bflo(b.y), bfhi(b.y)}; v[2 * j + 1] = (f32x4){bflo(b.z), bfhi(b.z), bflo(b.w), bfhi(b.w)}; }
#pragma unroll
        for (int j = 0; j < 4; ++j) s += (v[j][0] * v[j][0] + v[j][1] * v[j][1]) + (v[j][2] * v[j][2] + v[j][3] * v[j][3]);
        const float rs = __builtin_amdgcn_rsqf(wave_sum(s) * (1.0f / D) + EPS);
        if (m < T) { f32x4* orow = (f32x4*)(F.out + (size_t)m * D);
#pragma unroll
            for (int j = 0; j < 2; ++j) { orow[128 * j + 2 * F.lane] = v[2 * j] * rs * wv[2 * j]; orow[128 * j + 2 * F.lane + 1] = v[2 * j + 1] * rs * wv[2 * j + 1]; } } }
}

#ifndef CPU_EMU
#define XB_TMO      128
#define XB_XCNT(j)  (256  + 64 * (j))
#define XB_XSUB(j)  (1280 + 64 * (j))
#define XB_XGEN(j)  (2304 + 64 * (j))
#define XB_TOP      3328
#define XB_TOPGEN   3392
#define XCD_BAR_WORDS 3456
#define XB_SPIN_CAP (1u << 18)
DI unsigned xb_ld(unsigned* p)              { return __hip_atomic_load(p, __ATOMIC_RELAXED, __HIP_MEMORY_SCOPE_AGENT); }
DI unsigned xb_add(unsigned* p, unsigned v) { return __hip_atomic_fetch_add(p, v, __ATOMIC_RELAXED, __HIP_MEMORY_SCOPE_AGENT); }
DI unsigned xb_xcc_id() { return (unsigned)__builtin_amdgcn_s_getreg((3 << 11) | 20) & 0xFu; }
#define XB_SPIN(cond, bar) do { unsigned _sp = 0; while (cond) { __builtin_amdgcn_s_sleep(1); \
    if ((++_sp & 255u) == 0u) { if (xb_ld(&(bar)[XB_TMO])) break; if (_sp > XB_SPIN_CAP) { atomicAdd(&(bar)[XB_TMO], 1u); break; } } } } while (0)
struct XcdBarrier { unsigned* bar; unsigned x; volatile LAS unsigned* st; };
DI XcdBarrier xcd_barrier_post(unsigned* bar, volatile LAS unsigned* st) {
    XcdBarrier b; b.bar = bar; b.x = xb_xcc_id(); b.st = st;
    if (threadIdx.x == 0) (void)xb_add(&bar[XB_XCNT(b.x)], 1u);
    return b;
}
DI void xcd_barrier_complete(unsigned* bar, unsigned x, unsigned& nloc, unsigned& nx) {
    const unsigned G = gridDim.x * gridDim.y * gridDim.z;
    unsigned sum, cnt, mine, sp = 0u;
    for (;;) {
        sum = 0u; cnt = 0u; mine = 0u;
#pragma unroll
        for (unsigned j = 0; j < 16; ++j) { const unsigned c = xb_ld(&bar[XB_XCNT(j)]); sum += c; cnt += (c > 0u) ? 1u : 0u; mine = (j == x) ? c : mine; }
        if (sum == G) break;
        __builtin_amdgcn_s_sleep(1);
        if ((++sp & 255u) == 0u) { if (xb_ld(&bar[XB_TMO])) break; if (sp > XB_SPIN_CAP) { atomicAdd(&bar[XB_TMO], 1u); break; } }
    }
    nloc = mine > 0u ? mine : 1u; nx = cnt > 0u ? cnt : 1u;
}
DI void xcd_barrier(const XcdBarrier& b) {
    asm volatile("s_waitcnt vmcnt(0)" ::: "memory");
    __syncthreads();
    if (threadIdx.x == 0) {
        unsigned* bar = b.bar;
        __builtin_amdgcn_s_waitcnt(0);
        unsigned nloc = b.st[0], nx = b.st[1];
        if (nloc == 0u) { xcd_barrier_complete(bar, b.x, nloc, nx); b.st[0] = nloc; b.st[1] = nx; }
        const unsigned old = xb_add(&bar[XB_XSUB(b.x)], 1u);
        const unsigned gen = old / nloc;
        if (old + 1u == (gen + 1u) * nloc) {
            __builtin_amdgcn_fence(__ATOMIC_RELEASE, "agent");
            asm volatile("s_waitcnt vmcnt(0)" ::: "memory");
            const unsigned og = xb_add(&bar[XB_TOP], 1u);
            const unsigned tgt = (og / nx + 1u) * nx;
            if (og + 1u != tgt) XB_SPIN(xb_ld(&bar[XB_TOP]) < tgt, bar);
            __builtin_amdgcn_fence(__ATOMIC_ACQUIRE, "agent");
            xb_add(&bar[XB_XGEN(b.x)], 1u);
            asm volatile("s_waitcnt vmcnt(0)" ::: "memory");
        } else {
            XB_SPIN(xb_ld(&bar[XB_XGEN(b.x)]) == gen, bar);
            __builtin_amdgcn_fence(__ATOMIC_ACQUIRE, "agent");
            asm volatile("s_waitcnt vmcnt(0)" ::: "memory");
        }
    }
    __syncthreads();
}
#endif

constexpr int NPHASES = 17;
DI void run_phase(Frame& F, int ph) {
    using namespace pg8;
    StaticOrder S;
    switch (ph) {
    case 0: p0_prologue(F); break;
    case 1: { Gemm g{WSP(bf16_t, WS_W_IN0), D, 0}; AStd A{(const char*)WSP(bf16_t, WS_XN), D}; S.init(T, N0, F.G, (int)blockIdx.x); EpiProj E{WSP(bf16_t, WS_PROJ), N0, nullptr, 0, -1, nullptr, nullptr, nullptr, nullptr}; gemm_phase(F.lds, g, A, S, E); } break;
    case 2: l0_phase_a(F); break;
    case 3: l0_phase_b(F); break;
    case 4: l0_phase_c(F); break;
    case 5: { Gemm g{WSP(bf16_t, WS_W_OUT0), D, 0}; AStd A{(const char*)WSP(bf16_t, WS_MIX), D}; S.init(T, D, F.G, (int)blockIdx.x); EpiResid<true> E{F.in[0], XRES, WSP(float, WS_SSQ)}; gemm_phase(F.lds, g, A, S, E); } break;
    case 6: { Gemm g{WSP(bf16_t, WS_W_UP0), D, 0}; AStd A{(const char*)XRES, D}; S.init(T, DFF, F.G, (int)blockIdx.x); LAS float* rsl = (LAS float*)(F.lds + 131072); prep_rs(rsl, S, WSP(float, WS_SSQ)); EpiProj E{WSP(bf16_t, WS_PROJ), DFF, WSP(float, WS_SSQ), 1, -1, nullptr, nullptr, nullptr, rsl}; gemm_phase(F.lds, g, A, S, E); } break;
    case 7: { Gemm g{WSP(bf16_t, WS_W_DN0), DFF, 0}; AStd A{(const char*)WSP(bf16_t, WS_PROJ), DFF}; S.init(T, D, F.G, (int)blockIdx.x); EpiResid<false> E{nullptr, XRES, WSP(float, WS_SSQ)}; gemm_phase(F.lds, g, A, S, E); } break;
    case 8: { Gemm g{WSP(bf16_t, WS_W_IN1), D, 0}; AStd A{(const char*)XRES, D}; S.init(T, N1G, F.G, (int)blockIdx.x); LAS float* rsl = (LAS float*)(F.lds + 131072); prep_rs(rsl, S, WSP(float, WS_SSQ)); EpiProj E{WSP(bf16_t, WS_PROJ), N1, WSP(float, WS_SSQ), 0, 13, WSP(float, WS_BG), F.in[16], F.in[17], rsl}; gemm_phase(F.lds, g, A, S, E); } break;
    case 9: { Gemm g{WSP(bf16_t, WS_S5_H), 256, (size_t)256 * 256 * 2}; AS5 A{(const char*)(WSP(bf16_t, WS_PROJ) + 3072), (const char*)WSP(bf16_t, WS_S5_HP)}; BatchOrder B; B.init(T / 16 / 256, 16, F.G, (int)blockIdx.x);
              EpiS5State E{WSP(bf16_t, WS_S5_HL)}; gemm_phase(F.lds, g, A, B, E); } break;
    case 10: s5_state_scan(F); break;
    case 11: { const bool split = F.G > 96;
              const int bx = (int)blockIdx.x; const bool scan_wg = bx < 32 || (bx < 64 && (bx & 7) < 4);
              const int pidx = bx >= 64 ? bx - 64 + 16 : ((bx - 32) >> 3) * 4 + (bx & 7) - 4;
              if (!split) gdn_g1(F, bx, F.G);
              if (!split || scan_wg) gdn_g2(F);
              if (!split || !scan_wg) { if (split) gdn_g1(F, pidx, F.G - 48); __syncthreads(); Gemm g{WSP(bf16_t, WS_S5_MG), 384, (size_t)256 * 384 * 2}; AS5 A{(const char*)(WSP(bf16_t, WS_PROJ) + 3072), (const char*)WSP(bf16_t, WS_S5_HP)};
                  BatchOrder B; B.init(T / 16 / 256, 16, split ? F.G - 48 : F.G, split ? pidx : bx); EpiS5Y E{WSP(bf16_t, WS_YG)}; gemm_phase(F.lds, g, A, B, E); } } break;
    case 12: { Gemm g{WSP(bf16_t, WS_S5_WG), 256, 0}; AStd A{(const char*)WSP(bf16_t, WS_YG), 256}; S.init(T, 256, F.G, (int)blockIdx.x); EpiS5Glu E{F.in[28], WSP(bf16_t, WS_MIX)}; gemm_phase(F.lds, g, A, S, E); s5_glu_gate(F); gdn_g3(F); } break;
    case 13: { Gemm g{WSP(bf16_t, WS_W_OUT1), D, 0}; AStd A{(const char*)WSP(bf16_t, WS_MIX), D}; S.init(T, D, F.G, (int)blockIdx.x); EpiResid<false> E{nullptr, XRES, WSP(float, WS_SSQ)}; gemm_phase(F.lds, g, A, S, E); } break;
    case 14: { Gemm g{WSP(bf16_t, WS_W_UP1), D, 0}; AStd A{(const char*)XRES, D}; S.init(T, DFF, F.G, (int)blockIdx.x); LAS float* rsl = (LAS float*)(F.lds + 131072); prep_rs(rsl, S, WSP(float, WS_SSQ)); EpiProj E{WSP(bf16_t, WS_PROJ), DFF, WSP(float, WS_SSQ), 1, -1, nullptr, nullptr, nullptr, rsl}; gemm_phase(F.lds, g, A, S, E); } break;
    case 15: { Gemm g{WSP(bf16_t, WS_W_DN1), DFF, 0}; AStd A{(const char*)WSP(bf16_t, WS_PROJ), DFF}; S.init(T, D, F.G, (int)blockIdx.x); EpiResid<false> E{nullptr, XRES, WSP(float, WS_SSQ)}; gemm_phase(F.lds, g, A, S, E); } break;
    case 16: break;
#ifdef CPU_EMU
    case 100: { Gemm g{WSP(bf16_t, WS_S5_H), 256, (size_t)256 * 256 * 2}; AS5 A{(const char*)(WSP(bf16_t, WS_PROJ) + 3072), (const char*)WSP(bf16_t, WS_S5_HP)}; BatchOrder B; B.init(T / 16 / 256, 16, F.G, (int)blockIdx.x); EpiS5State E{WSP(bf16_t, WS_S5_HL)}; gemm_phase(F.lds, g, A, B, E); } break;
    case 101: s5_state_scan(F); break;
    case 102: { Gemm g{WSP(bf16_t, WS_S5_MG), 384, (size_t)256 * 384 * 2}; AS5 A{(const char*)(WSP(bf16_t, WS_PROJ) + 3072), (const char*)WSP(bf16_t, WS_S5_HP)}; BatchOrder B; B.init(T / 16 / 256, 16, F.G, (int)blockIdx.x); EpiS5Y E{WSP(bf16_t, WS_YG)}; gemm_phase(F.lds, g, A, B, E); } break;
    case 103: { Gemm g{WSP(bf16_t, WS_S5_WG), 256, 0}; AStd A{(const char*)WSP(bf16_t, WS_YG), 256}; S.init(T, 256, F.G, (int)blockIdx.x); EpiS5Glu E{F.in[28], WSP(bf16_t, WS_MIX)}; gemm_phase(F.lds, g, A, S, E); s5_glu_gate(F); } break;
#endif
    default: break;
    }
}

template <int PH> __global__ void __launch_bounds__(NTHREADS, 2) phase_kernel(Params p) {
#ifndef CPU_EMU
    extern __shared__ __attribute__((aligned(16))) unsigned char lds_raw[];
    LAS unsigned char* lds = (LAS unsigned char*)lds_raw;
#else
    unsigned char* lds = emu::cur->blk->lds;
#endif
    Frame F;
    F.lds = lds; F.tid = threadIdx.x; F.lane = F.tid & 63; F.wave = __builtin_amdgcn_readfirstlane(F.tid >> 6); F.G = gridDim.x;
    F.gtid = (long)blockIdx.x * NTHREADS + F.tid; F.gthreads = (long)F.G * NTHREADS; F.gwave = (int)blockIdx.x * (NTHREADS / 64) + F.wave; F.gwaves = F.G * (NTHREADS / 64);
#ifndef CPU_EMU
    F.in.q = (const KAS Params*)__builtin_amdgcn_kernarg_segment_ptr();
#else
    F.in.q = &p;
#endif
    F.out = p.out; F.ws = p.ws;
    if (PH == NPHASES - 1) { for (int bt = 0; bt * 16 * F.gwaves < T; ++bt) { u32x4 rows[16][2]; final_norm_load(F, bt, rows); cg::this_grid().sync(); final_norm_store(F, bt, rows); if ((bt + 1) * 16 * F.gwaves < T) cg::this_grid().sync(); } }
    run_phase(F, PH);
}
#if N_LAUNCH_MODE == 1 || defined(CPU_EMU)
#ifndef CPU_EMU
#define GRID_SEAM(ph) do { if ((ph) == 0) cg::this_grid().sync(); else xcd_barrier(xb); } while (0)
template <int PH> DI void run_all(Frame& F, int hi, const XcdBarrier& xb) {
#else
#define GRID_SEAM(ph) cg::this_grid().sync()
template <int PH> DI void run_all(Frame& F, int hi, int xb) {
#endif
    if constexpr (PH < NPHASES) {
        if (PH < hi) {
#ifndef CPU_EMU
            asm volatile("" : "+s"(F.in.q));
#endif
            F.out = F.in.q->out; F.ws = F.in.q->ws;
            if (PH == NPHASES - 1) { for (int bt = 0; bt * 16 * F.gwaves < T; ++bt) { u32x4 rows[16][2]; final_norm_load(F, bt, rows); GRID_SEAM(1); final_norm_store(F, bt, rows); if ((bt + 1) * 16 * F.gwaves < T) GRID_SEAM(1); } }
            run_phase(F, PH); if (PH == PROBE_REPEAT) { GRID_SEAM(1); if (PH == 11) { if (G2_PROBE_MODE == 9) gdn_g1(F, (int)blockIdx.x, F.G); else if ((int)blockIdx.x < 64) gdn_g2(F, G2_PROBE_MODE); } else run_phase(F, PH); }
            if (PH + 1 < hi) GRID_SEAM(PH); }
        run_all<PH + 1>(F, hi, xb);
    }
}
__global__ void __launch_bounds__(NTHREADS, 2) fwd_kernel(Params p) {
#ifndef CPU_EMU
    extern __shared__ __attribute__((aligned(16))) unsigned char lds_raw[];
    LAS unsigned char* lds = (LAS unsigned char*)lds_raw;
#else
    unsigned char* lds = emu::cur->blk->lds;
#endif
    Frame F;
    F.lds = lds; F.tid = threadIdx.x; F.lane = F.tid & 63; F.wave = __builtin_amdgcn_readfirstlane(F.tid >> 6); F.G = gridDim.x;
    F.gtid = (long)blockIdx.x * NTHREADS + F.tid; F.gthreads = (long)F.G * NTHREADS; F.gwave = (int)blockIdx.x * (NTHREADS / 64) + F.wave; F.gwaves = F.G * (NTHREADS / 64);
#ifndef CPU_EMU
    F.in.q = (const KAS Params*)__builtin_amdgcn_kernarg_segment_ptr();
#else
    F.in.q = &p;
#endif
#ifndef CPU_EMU
    volatile LAS unsigned* xst = (volatile LAS unsigned*)(lds + LDS_BYTES - 16);
    if (threadIdx.x == 0) { xst[0] = 0u; xst[1] = 0u; }
    __syncthreads();
    const XcdBarrier xb = xcd_barrier_post((unsigned*)(p.ws + WS_CTL), xst);
    run_all<0>(F, p.ph_hi, xb);
#else
    run_all<0>(F, p.ph_hi, 0);
#endif
}
#endif
template <int PH> static void launch_phases(Params& p, int grid, hipStream_t stream) {
    if constexpr (PH < NPHASES) {
#ifndef CPU_EMU
        static bool attr = false;
        if (!attr) { (void)hipFuncSetAttribute((const void*)phase_kernel<PH>, hipFuncAttributeMaxDynamicSharedMemorySize, LDS_BYTES); attr = true; }
        hipLaunchKernelGGL(phase_kernel<PH>, dim3(grid), dim3(NTHREADS), LDS_BYTES, stream, p);
#endif
        launch_phases<PH + 1>(p, grid, stream);
    }
}

#ifndef CPU_EMU
#if N_LAUNCH_MODE == 1
#define MAIN_KERNEL fwd_kernel
#else
#define MAIN_KERNEL phase_kernel<1>
#endif
extern "C" void kernel_launch(void* const* d_in, const int* in_sizes, int n_in, void* d_out, int out_size, void* d_ws, size_t ws_size, hipStream_t stream) {
    static int grid = 0;
    if (grid == 0) {
        if (n_in != 34 || out_size != T * D || ws_size < WS_END) { fprintf(stderr, "kernel_launch: unexpected shapes (n_in %d out %d ws %zu need %zu)\n", n_in, out_size, ws_size, (size_t)WS_END); grid = -1; return; }
        int dev = 0, cus = 0, per_cu = 0;
        (void)hipGetDevice(&dev); (void)hipDeviceGetAttribute(&cus, hipDeviceAttributeMultiprocessorCount, dev);
        if (hipFuncSetAttribute((const void*)MAIN_KERNEL, hipFuncAttributeMaxDynamicSharedMemorySize, LDS_BYTES) != hipSuccess) { fprintf(stderr, "kernel_launch: hipFuncSetAttribute failed\n"); grid = -1; return; }
        if (hipOccupancyMaxActiveBlocksPerMultiprocessor(&per_cu, (const void*)MAIN_KERNEL, NTHREADS, LDS_BYTES) != hipSuccess || per_cu < 1) { fprintf(stderr, "kernel_launch: occupancy query says %d\n", per_cu); per_cu = 1; }
        (void)hipGetLastError();
        grid = cus;
    }
    if (grid < 0) return;
    Params p{};
    for (int i = 0; i < 34; ++i) p.in[i] = (const float*)d_in[i];
    p.out = (float*)d_out; p.ws = (unsigned char*)d_ws;
#if N_LAUNCH_MODE == 1
    if (hipMemsetAsync((char*)d_ws + WS_CTL, 0, 32768, stream) != hipSuccess) { fprintf(stderr, "kernel_launch: hipMemsetAsync failed\n"); return; }
    p.ph_lo = 0; p.ph_hi = NPHASES;
    void* args[] = {&p};
    hipError_t e = hipLaunchCooperativeKernel((const void*)fwd_kernel, dim3(grid), dim3(NTHREADS), args, LDS_BYTES, stream);
    if (e != hipSuccess) fprintf(stderr, "kernel_launch: cooperative launch failed: %s (grid %d)\n", hipGetErrorString(e), grid);
#else
    launch_phases<0>(p, grid, stream);
#endif
}
#endif
```

```cpp
#ifndef CPU_EMU
#include <hip/hip_runtime.h>
#include <hip/hip_cooperative_groups.h>
#include <cstdio>
#define LAS __attribute__((address_space(3)))
#define GLDS16(g, l) __builtin_amdgcn_global_load_lds((const unsigned*)(g), (LAS unsigned*)(l), 16, 0, 0)
#define WAIT_V(n) asm volatile("s_waitcnt vmcnt(" #n ")" ::: "memory")
#define WAIT_L(n) asm volatile("s_waitcnt lgkmcnt(" #n ")" ::: "memory")
#else
#define LAS
#define GLDS16(g, l) memcpy((unsigned char*)(l) + 16 * (threadIdx.x & 63), (const void*)(g), 16)
#define WAIT_V(n) emu::wave_barrier()
#define WAIT_L(n) emu::wave_barrier()
#endif
namespace cg = cooperative_groups;
#define DI __device__ __forceinline__
#ifndef CPU_EMU
#define OPAQUE_V(x) asm volatile("" : "+v"(x))
#else
#define OPAQUE_V(x) ((void)0)
#endif

#ifndef SEQ_LEN
#define SEQ_LEN 16384
#endif
#ifndef PROBE_REPEAT
#define PROBE_REPEAT -1
#endif
#ifndef N_LAUNCH_MODE
#define N_LAUNCH_MODE 1
#endif

typedef unsigned short bf16_t;
typedef short bf16x8 __attribute__((ext_vector_type(8)));
typedef float f32x4 __attribute__((ext_vector_type(4)));
typedef float f32x2 __attribute__((ext_vector_type(2)));
typedef unsigned u32x4 __attribute__((ext_vector_type(4)));
typedef unsigned u32x2 __attribute__((ext_vector_type(2)));

constexpr int BATCH = 2, L = SEQ_LEN, T = BATCH * L, NCHT = T / 64  , D = 1024, DFF = 4096;
constexpr int N0 = 3584;
constexpr int N0SRC = 3592;
constexpr int N1 = 3328;
constexpr int N1SRC = 3340;
constexpr int N1G = 3584;
constexpr float EPS = 1e-6f;
constexpr int NTHREADS = 512, LDS_BYTES = 147456;

constexpr size_t MiB = 1u << 20;
constexpr size_t WS_CTL = 0;
constexpr size_t WS_W_IN0 = 1 * MiB, WS_W_OUT0 = WS_W_IN0 + (size_t)N0 * D * 2, WS_W_UP0 = WS_W_OUT0 + (size_t)D * D * 2, WS_W_DN0 = WS_W_UP0 + (size_t)DFF * D * 2,
                 WS_W_IN1 = WS_W_DN0 + (size_t)D * DFF * 2, WS_W_OUT1 = WS_W_IN1 + (size_t)N1G * D * 2, WS_W_UP1 = WS_W_OUT1 + (size_t)D * D * 2, WS_W_DN1 = WS_W_UP1 + (size_t)DFF * D * 2,
                 WS_W_END = WS_W_DN1 + (size_t)D * DFF * 2;
static_assert(WS_W_END <= 52 * MiB, "weights");
constexpr size_t WS_YG = WS_W_IN0;
constexpr size_t WS_ROPE = 52 * MiB;
constexpr size_t WS_S5C = WS_ROPE + (size_t)L * 64 * 8;
constexpr size_t WS_WDT = WS_S5C + 16 * 64 * 8 + 16 * 64 * 16 * 8;
constexpr size_t WS_SMALL = ((WS_WDT + 1024 * 8 * 4 + 4095) / 4096) * 4096;
constexpr size_t WS_DT = WS_SMALL;
constexpr size_t WS_BG = WS_DT + (size_t)T * 8 * 4;
constexpr size_t WS_LAC = WS_BG + (size_t)T * 16 * 4;
constexpr size_t WS_GC = WS_LAC + (size_t)T * 8 * 4;
constexpr size_t WS_SSQ = WS_GC + (size_t)T * 8 * 4;
constexpr size_t WS_XN = ((WS_SSQ + (size_t)T * 16 * 4 + MiB - 1) / MiB) * MiB;
constexpr size_t WS_MIX = WS_XN + (size_t)T * D * 2;
constexpr size_t WS_PROJ = WS_MIX + (size_t)T * D * 2;
constexpr size_t WS_TAIL = WS_PROJ + (size_t)T * DFF * 2;
constexpr size_t WS_S5_H = WS_TAIL + (size_t)T * 1536;
constexpr size_t WS_S5_MG = WS_S5_H + 16 * 256 * 256 * 2;
constexpr size_t WS_S5_WG = WS_S5_MG + 16 * 256 * 384 * 2;
constexpr size_t WS_END = WS_S5_WG + 256 * 256 * 2;
constexpr size_t WS_S5_HL = WS_XN + (size_t)T * 3840;
constexpr size_t WS_S5_HP = WS_ROPE;
static_assert(SEQ_LEN != 16384 || WS_END <= 512 * MiB, "workspace");

struct Params { const float* in[34]; float* out; unsigned char* ws; int ph_lo, ph_hi; };

DI float bf2f(bf16_t b) { return __uint_as_float(((unsigned)b) << 16); }
DI bf16_t f2bf(float f) { unsigned u = __float_as_uint(f); return (bf16_t)((u + 0x7fffu + ((u >> 16) & 1u)) >> 16); }
DI unsigned pk2(float lo, float hi) { return (unsigned)f2bf(lo) | ((unsigned)f2bf(hi) << 16); }
#ifndef CPU_EMU
typedef __bf16 bf16v2_t __attribute__((ext_vector_type(2)));
DI unsigned cvt_pk_bf16(float lo, float hi) { bf16v2_t v; v[0] = (__bf16)lo; v[1] = (__bf16)hi; return __builtin_bit_cast(unsigned, v); }
#else
DI unsigned cvt_pk_bf16(float lo, float hi) { return pk2(lo, hi); }
#endif
DI float silu_f(float x) { return x * __builtin_amdgcn_rcpf(1.0f + __expf(-x)); }
DI float silu_fast(float x) { return x * __builtin_amdgcn_rcpf(1.0f + __expf(-x)); }
DI float sigmoid_f(float x) { return __builtin_amdgcn_rcpf(1.0f + __expf(-x)); }
DI float softplus_f(float x) { return x > 20.0f ? x : log1pf(expf(x)); }
DI float gelu_tanh_f(float x) { const float u = 0.7978845608028654f * (x + 0.044715f * x * x * x); return x * (1.0f - __builtin_amdgcn_rcpf(1.0f + __expf(2.0f * u))); }
DI float wave_sum(float v) {
#pragma unroll
    for (int o = 1; o < 64; o <<= 1) v += __shfl_xor(v, o);
    return v;
}
DI bf16x8 ldsfrag(const LAS bf16_t* base, int row, int col, int pitch) { return *(const LAS bf16x8*)(base + row * pitch + col); }
DI bf16x8 pack8(const f32x4 a, const f32x4 b) { u32x4 w; w.x = cvt_pk_bf16(a[0], a[1]); w.y = cvt_pk_bf16(a[2], a[3]); w.z = cvt_pk_bf16(b[0], b[1]); w.w = cvt_pk_bf16(b[2], b[3]); return __builtin_bit_cast(bf16x8, w); }
DI float sel4(const f32x4 v, int i) { return i == 0 ? v[0] : i == 1 ? v[1] : i == 2 ? v[2] : v[3]; }
DI void sincos_rev(double rev, double& s, double& c) {
    const double fr = rev - rint(rev); const double q = rint(fr * 4.0); const double r = (fr - q * 0.25) * 6.283185307179586476925; const double r2 = r * r;
    const double sr = r * (1.0 + r2 * (-1.0 / 6.0 + r2 * (1.0 / 120.0 + r2 * (-1.0 / 5040.0 + r2 * (1.0 / 362880.0 + r2 * (-1.0 / 39916800.0 + r2 * (1.0 / 6227020800.0)))))));
    const double cr = 1.0 + r2 * (-0.5 + r2 * (1.0 / 24.0 + r2 * (-1.0 / 720.0 + r2 * (1.0 / 40320.0 + r2 * (-1.0 / 3628800.0 + r2 * (1.0 / 479001600.0 + r2 * (-1.0 / 87178291200.0)))))));
    const int qi = ((int)q) & 3;
    s = qi == 0 ? sr : qi == 1 ? cr : qi == 2 ? -sr : -cr;
    c = qi == 0 ? cr : qi == 1 ? -sr : qi == 2 ? -cr : sr;
}

namespace pg8 {
constexpr int BM = 256, BK = 64, HALF = 128, HTB = HALF * BK * 2, STAGE_BYTES = 8 * HTB, NXCD = 8, WGM = 8;
DI int lds_byte(int r, int c) { const int st = (r >> 4) * 2 + (c >> 5), rr = r & 15, cc = c & 31, ob = rr * 64 + cc * 2; return st * 1024 + (ob ^ (((ob >> 9) & 1) << 5)); }
DI void stage_rc(int b, int& R, int& C) { const int st = b / 1024, sb = b % 1024, swz = sb ^ (((sb >> 9) & 1) << 5); R = (st >> 1) * 16 + swz / 64; C = (st & 1) * 32 + (swz % 64) / 2; }
DI int perm32(int rho) { const int n = rho >> 4, i = rho & 15; return 8 * (i >> 2) + 4 * n + (i & 3); }
struct Unit { int pm, pn, g, ord; };
struct Gemm { const bf16_t* Bt; int K; size_t bgroup; };
struct StaticOrder {
    int nM, nN, nwg, G, c;
    DI void init(int M, int N, int G_, int c_) { nM = M / BM; nN = N / BM; nwg = nM * nN; G = G_; c = c_; }
    DI bool next(int i, Unit& u) const {
        const long Lx = (long)i * G + c; if (Lx >= nwg) return false;
        int wgid = (int)Lx; { const int q = nwg / NXCD, r = nwg % NXCD, xcd = wgid % NXCD, off = wgid / NXCD; wgid = (xcd < r ? xcd * (q + 1) : r * (q + 1) + (xcd - r) * q) + off; }
        const int nig = WGM * nN, gid = wgid / nig, fm = gid * WGM, gsz = (nM - fm) < WGM ? (nM - fm) : WGM;
        u.pm = fm + ((wgid % nig) % gsz); u.pn = (wgid % nig) / gsz; u.g = 0; return true;
    }
};
struct BatchOrder {
    int nM, nwg, G, c;
    DI void init(int nM_, int ngroups, int G_, int c_) { nM = nM_; nwg = nM_ * ngroups; G = G_; c = c_; }
    DI bool next(int i, Unit& u) const { if (c < 0) return false; const long Lx = (long)i * G + c; if (Lx >= nwg) return false; u.g = (int)Lx / nM; u.pm = (int)Lx % nM; u.pn = 0; return true; }
};
struct AStd {
    const char* A; int K; unsigned v[2];
    DI void lane_init(int tid) {
#pragma unroll
        for (int i = 0; i < 2; ++i) { int R, C; stage_rc(tid * 16 + i * 8192, R, C); v[i] = (unsigned)(R * K + C) * 2u; } }
    DI const char* tile(const Unit& u, int half, int t) const { return A + ((size_t)u.pm * 256 + half * 128) * K * 2 + (size_t)t * 128; }
    DI const unsigned* voff(int) const { return v; }
};
struct AS5 {
    const char* U; const char* HP; unsigned vu[2], vh[2];
    static constexpr size_t ROWP = (size_t)16 * N1 * 2;
    DI void lane_init(int tid) {
#pragma unroll
        for (int i = 0; i < 2; ++i) { int R, C; stage_rc(tid * 16 + i * 8192, R, C); vu[i] = (unsigned)((size_t)R * ROWP + (size_t)(C >> 4) * N1 * 2 + (C & 15) * 2); vh[i] = (unsigned)(R * 256 + C * 2); } }
    DI const char* tile(const Unit& u, int half, int t) const {
        return t < 4 ? U + (size_t)u.g * 32 + ((size_t)u.pm * 256 + half * 128) * ROWP + (size_t)t * 4 * N1 * 2 : HP + (((size_t)u.g * (T / 16) + (size_t)u.pm * 256 + half * 128) * 128 + (size_t)(t - 4) * 64) * 2; }
    DI const unsigned* voff(int t) const { return t < 4 ? vu : vh; }
};
#ifndef CPU_EMU
DI void store16_wt(void* p, const u32x4 v) { asm volatile("global_store_dwordx4 %0, %1, off sc1\n\ts_nop 1" :: "v"(p), "v"(v) : "memory"); }
DI void store4_wt(void* p, const float v) { asm volatile("global_store_dword %0, %1, off sc1\n\ts_nop 1" :: "v"(p), "v"(v) : "memory"); }
DI void store4u_wt(void* p, const unsigned v) { asm volatile("global_store_dword %0, %1, off sc1\n\ts_nop 1" :: "v"(p), "v"(v) : "memory"); }
DI void store8_wt(void* p, const u32x2 v) { asm volatile("global_store_dwordx2 %0, %1, off sc1\n\ts_nop 1" :: "v"(p), "v"(v) : "memory"); }
#else
DI void store16_wt(void* p, const u32x4 v) { *(u32x4*)p = v; }
DI void store4_wt(void* p, const float v) { *(float*)p = v; }
DI void store4u_wt(void* p, const unsigned v) { *(unsigned*)p = v; }
DI void store8_wt(void* p, const u32x2 v) { *(u32x2*)p = v; }
#endif
DI float row_rs(const float* ssq, int row) {
    const f32x4* p = (const f32x4*)(ssq + (size_t)row * 16); const f32x4 a = p[0], b = p[1], c = p[2], d = p[3];
    const float s = ((a[0] + a[1]) + (a[2] + a[3])) + ((b[0] + b[1]) + (b[2] + b[3])) + ((c[0] + c[1]) + (c[2] + c[3])) + ((d[0] + d[1]) + (d[2] + d[3]));
    return 1.0f / sqrtf(s * (1.0f / 1024.0f) + EPS);
}
template <class Ord> DI void prep_rs(LAS float* rsl, const Ord& S, const float* ssq) {
    const int par = (int)threadIdx.x >> 8, r = (int)threadIdx.x & 255; f32x4 v[4][4]; bool ok[4];
#pragma unroll
    for (int j = 0; j < 4; ++j) { Unit u; ok[j] = S.next(par + 2 * j, u);
        if (ok[j]) { const f32x4* p = (const f32x4*)(ssq + (size_t)(u.pm * BM + r) * 16); v[j][0] = p[0]; v[j][1] = p[1]; v[j][2] = p[2]; v[j][3] = p[3]; } }
#pragma unroll
    for (int j = 0; j < 4; ++j) if (ok[j]) { const f32x4 a = v[j][0], b = v[j][1], c = v[j][2], d = v[j][3];
        const float s = ((a[0] + a[1]) + (a[2] + a[3])) + ((b[0] + b[1]) + (b[2] + b[3])) + ((c[0] + c[1]) + (c[2] + c[3])) + ((d[0] + d[1]) + (d[2] + d[3]));
        rsl[(par + 2 * j) * 256 + r] = __builtin_amdgcn_rsqf(s * (1.0f / 1024.0f) + EPS); }
    __syncthreads();
}
struct EpiProj {
    static constexpr bool PERM = true;
    bf16_t* O; int ldc; const float* ssq; int act; int ba_pn; float* bg; const float* alog; const float* dtb; const LAS float* rsl;
    DI void operator()(const f32x4 (&acc)[2][2][4][2], const Unit& u, int wr, int wc, int fr, int fq, bool lastu) const {
        const int row0 = u.pm * BM + wr * 64 + fr, col0 = u.pn * BM + wc * 32 + 8 * fq;
        if (u.pn == ba_pn) {
            if (wc == 0 && fq < 2) {
#pragma unroll
                for (int ai = 0; ai < 2; ++ai)
#pragma unroll
                    for (int m = 0; m < 4; ++m) { const int row = row0 + ai * HALF + m * 16; const float rs = rsl[u.ord * 256 + wr * 64 + fr + ai * HALF + m * 16]; float* o = bg + (size_t)row * 16;
#pragma unroll
                        for (int n = 0; n < 2; ++n) *(f32x4*)(o + 8 * fq + 4 * n) = acc[ai][0][m][n] * rs; }
            }
            return;
        }
#pragma unroll
        for (int ai = 0; ai < 2; ++ai)
#pragma unroll
            for (int m = 0; m < 4; ++m) { const int row = row0 + ai * HALF + m * 16; const float rs = ssq ? rsl[u.ord * 256 + wr * 64 + fr + ai * HALF + m * 16] : 1.0f; bf16_t* rowp = O + (size_t)row * ldc + col0;
#pragma unroll
                for (int bj = 0; bj < 2; ++bj) { f32x4 v0 = acc[ai][bj][m][0] * rs, v1 = acc[ai][bj][m][1] * rs;
                    if (act == 1) {
#pragma unroll
                        for (int j = 0; j < 4; ++j) { const float a0 = v0[j] > 0.f ? v0[j] : 0.f, a1 = v1[j] > 0.f ? v1[j] : 0.f; v0[j] = a0 * a0; v1[j] = a1 * a1; } }
                    u32x4 w; w.x = cvt_pk_bf16(v0[0], v0[1]); w.y = cvt_pk_bf16(v0[2], v0[3]); w.z = cvt_pk_bf16(v1[0], v1[1]); w.w = cvt_pk_bf16(v1[2], v1[3]);
                    if (lastu) store16_wt(rowp + bj * HALF, w); else *(u32x4*)(rowp + bj * HALF) = w; } }
    }
};
template <bool BASE_F32> struct EpiResid {
    static constexpr bool PERM = true;
    const float* basef; bf16_t* xr; float* ssq;
    DI void fin(const f32x4 (&acc)[2][2][4][2], const Unit& u, int wc, int fq, int row, size_t off, int ai, int m, const f32x4 (&b)[2][2], bool wt) const { float ss = 0.f;
#pragma unroll
        for (int bj = 0; bj < 2; ++bj) { const f32x4 o0 = b[bj][0] + acc[ai][bj][m][0], o1 = b[bj][1] + acc[ai][bj][m][1];
            ss += ((o0[0] * o0[0] + o0[1] * o0[1]) + (o0[2] * o0[2] + o0[3] * o0[3])) + ((o1[0] * o1[0] + o1[1] * o1[1]) + (o1[2] * o1[2] + o1[3] * o1[3]));
            u32x4 w; w.x = cvt_pk_bf16(o0[0], o0[1]); w.y = cvt_pk_bf16(o0[2], o0[3]); w.z = cvt_pk_bf16(o1[0], o1[1]); w.w = cvt_pk_bf16(o1[2], o1[3]); if (wt) store16_wt(xr + off + bj * HALF, w); else *(u32x4*)(xr + off + bj * HALF) = w; }
        ss += __shfl_xor(ss, 16); ss += __shfl_xor(ss, 32);
        if (fq == 0) ssq[(size_t)row * 16 + u.pn * 4 + wc] = ss; }
    DI void operator()(const f32x4 (&acc)[2][2][4][2], const Unit& u, int wr, int wc, int fr, int fq, bool lastu) const {
        const int row0 = u.pm * BM + wr * 64 + fr, col0 = u.pn * BM + wc * 32 + 8 * fq;
        if constexpr (BASE_F32) {
            f32x4 b0[2][2], b1[2][2], b2[2][2];
            auto ldb = [&](int k, f32x4 (&b)[2][2]) { const int ai = k >> 2, m = k & 3;
#pragma unroll
                for (int bj = 0; bj < 2; ++bj) { const size_t o2 = (size_t)(row0 + ai * HALF + m * 16) * D + col0 + bj * HALF; b[bj][0] = *(const f32x4*)(basef + o2); b[bj][1] = *(const f32x4*)(basef + o2 + 4); } };
            auto fnb = [&](int k, const f32x4 (&b)[2][2]) { const int ai = k >> 2, m = k & 3, row = row0 + ai * HALF + m * 16; fin(acc, u, wc, fq, row, (size_t)row * D + col0, ai, m, b, lastu); };
            ldb(0, b0); ldb(1, b1); ldb(2, b2); fnb(0, b0); ldb(3, b0); fnb(1, b1); ldb(4, b1); fnb(2, b2); ldb(5, b2); fnb(3, b0); ldb(6, b0); fnb(4, b1); ldb(7, b1); fnb(5, b2); fnb(6, b0); fnb(7, b1);
        } else {
            u32x4 b0[2][2], b1[2][2], b2[2][2];
            auto ldb = [&](int k, u32x4 (&b)[2][2]) { const int ai = k >> 1, mh = k & 1;
#pragma unroll
                for (int mm = 0; mm < 2; ++mm)
#pragma unroll
                    for (int bj = 0; bj < 2; ++bj) b[mm][bj] = *(const u32x4*)(xr + (size_t)(row0 + ai * HALF + (2 * mh + mm) * 16) * D + col0 + bj * HALF); };
            auto fnb = [&](int k, const u32x4 (&bq)[2][2]) { const int ai = k >> 1, mh = k & 1;
#pragma unroll
                for (int mm = 0; mm < 2; ++mm) { const int m = 2 * mh + mm, row = row0 + ai * HALF + m * 16; f32x4 b[2][2];
#pragma unroll
                    for (int bj = 0; bj < 2; ++bj) { const u32x4 q = bq[mm][bj];
                        b[bj][0] = (f32x4){__uint_as_float(q.x << 16), __uint_as_float(q.x & 0xffff0000u), __uint_as_float(q.y << 16), __uint_as_float(q.y & 0xffff0000u)};
                        b[bj][1] = (f32x4){__uint_as_float(q.z << 16), __uint_as_float(q.z & 0xffff0000u), __uint_as_float(q.w << 16), __uint_as_float(q.w & 0xffff0000u)}; }
                    fin(acc, u, wc, fq, row, (size_t)row * D + col0, ai, m, b, lastu); } };
            ldb(0, b0); ldb(1, b1); ldb(2, b2); fnb(0, b0); ldb(3, b0); fnb(1, b1); fnb(2, b2); fnb(3, b0);
        }
    }
};
struct EpiS5State {
    static constexpr bool PERM = true;
    bf16_t* HL;
    DI void operator()(const f32x4 (&acc)[2][2][4][2], const Unit& u, int wr, int wc, int fr, int fq, bool lastu) const {
        const int row0 = u.pm * BM + wr * 64 + fr, col0 = wc * 32 + 8 * fq;
#pragma unroll
        for (int ai = 0; ai < 2; ++ai)
#pragma unroll
            for (int m = 0; m < 4; ++m) { const int row = row0 + ai * HALF + m * 16; const f32x4 v0 = acc[ai][0][m][0], v1 = acc[ai][0][m][1];
                u32x4 w; w.x = cvt_pk_bf16(v0[0], v0[1]); w.y = cvt_pk_bf16(v0[2], v0[3]); w.z = cvt_pk_bf16(v1[0], v1[1]); w.w = cvt_pk_bf16(v1[2], v1[3]);
                *(u32x4*)(HL + ((size_t)u.g * (T / 16) + row) * 128 + col0) = w; }
    }
};
struct EpiS5Y {
    static constexpr bool PERM = false;
    bf16_t* YGp;
    DI void operator()(const f32x4 (&acc)[2][2][4][2], const Unit& u, int wr, int wc, int fr, int fq, bool lastu) const {
        const int row0 = u.pm * BM + wr * 64 + fr, col0 = wc * 32 + 4 * fq;
#pragma unroll
        for (int ai = 0; ai < 2; ++ai)
#pragma unroll
            for (int m = 0; m < 4; ++m) { const int row = row0 + ai * HALF + m * 16;
#pragma unroll
                for (int bj = 0; bj < 2; ++bj)
#pragma unroll
                    for (int n = 0; n < 2; ++n) { const int col = col0 + bj * HALF + n * 16, l = col >> 4, c = col & 15; const f32x4 v = acc[ai][bj][m][n];
                        u32x2 w; w.x = cvt_pk_bf16(gelu_tanh_f(v[0]), gelu_tanh_f(v[1])); w.y = cvt_pk_bf16(gelu_tanh_f(v[2]), gelu_tanh_f(v[3]));
                        *(u32x2*)(YGp + ((size_t)row * 16 + l) * 256 + u.g * 16 + c) = w; } }
    }
};
DI float fast_sigmoid(float x) { return __builtin_amdgcn_rcpf(1.0f + __expf(-x)); }
struct EpiS5Glu {
    static constexpr bool PERM = true;
    const float* bglu; bf16_t* mix;
    DI void operator()(const f32x4 (&acc)[2][2][4][2], const Unit& u, int wr, int wc, int fr, int fq, bool lastu) const {
        const int row0 = u.pm * BM + wr * 64 + fr, col0 = wc * 32 + 8 * fq;
        f32x4 bv[2][2];
#pragma unroll
        for (int bj = 0; bj < 2; ++bj)
#pragma unroll
            for (int n = 0; n < 2; ++n) bv[bj][n] = *(const f32x4*)(bglu + col0 + bj * HALF + 4 * n);
#pragma unroll
        for (int ai = 0; ai < 2; ++ai)
#pragma unroll
            for (int m = 0; m < 4; ++m) { bf16_t* rowp = mix + (size_t)(row0 + ai * HALF + m * 16) * 1024 + 768 + col0;
#pragma unroll
                for (int bj = 0; bj < 2; ++bj) { const f32x4 v0 = acc[ai][bj][m][0] + bv[bj][0], v1 = acc[ai][bj][m][1] + bv[bj][1];
                    u32x4 w; w.x = cvt_pk_bf16(v0[0], v0[1]); w.y = cvt_pk_bf16(v0[2], v0[3]); w.z = cvt_pk_bf16(v1[0], v1[1]); w.w = cvt_pk_bf16(v1[2], v1[3]);
                    *(u32x4*)(rowp + bj * HALF) = w; } }
    }
};

template <bool ALIGN_EPI = true, bool SP2 = true, class Epi, class AP, class Ord>
DI void gemm_phase(LAS unsigned char* lds, const Gemm g, AP A, const Ord& S, const Epi& E) {
    const int tid = threadIdx.x, wid = __builtin_amdgcn_readfirstlane(tid >> 6), lane = tid & 63, wr = wid >> 2, wc = wid & 3, fr = lane & 15, fq = lane >> 4;
    const int K = g.K, nt = K / BK;
    unsigned voffB[2];
    A.lane_init(tid);
#pragma unroll
    for (int i = 0; i < 2; ++i) { int R, C; stage_rc(tid * 16 + i * 8192, R, C); const int Rb = Epi::PERM ? ((R & ~31) + perm32(R & 31)) : R; voffB[i] = (unsigned)(Rb * K + C) * 2u; }
    const size_t kstep = (size_t)(BK * 2);
    const size_t hstep = (size_t)HALF * K * 2;
    const size_t tstep = 2 * hstep;
    const unsigned ldsw = (unsigned)wid * 1024u;
    const int aoff = lds_byte(wr * 64 + fr, fq * 8), boff = lds_byte(wc * 32 + fr, fq * 8);
#define PG8_SA(b, h) (((b) * 2 + (h)) * HTB)
#define PG8_SB(b, h) ((4 + (b) * 2 + (h)) * HTB)
#define PG8_STAGE(bufoff, gbase, voff) do { _Pragma("unroll") for (int _i = 0; _i < 2; ++_i) \
        GLDS16((const char*)(gbase) + (voff)[_i], lds + (bufoff) + ldsw + _i * 8192); } while (0)
#define PG8_LDA(dst, b, h) do { _Pragma("unroll") for (int m = 0; m < 4; ++m) _Pragma("unroll") for (int k = 0; k < 2; ++k) dst[m][k] = *(const LAS bf16x8*)(lds + PG8_SA(b, h) + aoff + m * 2048 + k * 1024); } while (0)
#define PG8_LDB(dst, b, h) do { _Pragma("unroll") for (int n = 0; n < 2; ++n) _Pragma("unroll") for (int k = 0; k < 2; ++k) dst[n][k] = *(const LAS bf16x8*)(lds + PG8_SB(b, h) + boff + n * 2048 + k * 1024); } while (0)
#define PG8_MMA(ai, bj, At, Bt) do { __builtin_amdgcn_s_setprio(1); _Pragma("unroll") for (int m = 0; m < 4; ++m) _Pragma("unroll") for (int n = 0; n < 2; ++n) _Pragma("unroll") for (int k = 0; k < 2; ++k) \
        acc[ai][bj][m][n] = __builtin_amdgcn_mfma_f32_16x16x32_bf16(Bt[n][k], At[m][k], acc[ai][bj][m][n], 0, 0, 0); __builtin_amdgcn_s_setprio(0); } while (0)
#define PG8_BAR __builtin_amdgcn_s_barrier()
#define PG8_SCHED __builtin_amdgcn_sched_barrier(0)
    Unit cur, nxt; int ui = 0;
    if (!S.next(0, cur)) return;
    cur.ord = 0;
    f32x4 acc[2][2][4][2];
#pragma unroll
    for (int a = 0; a < 2; ++a)
#pragma unroll
        for (int b = 0; b < 2; ++b)
#pragma unroll
            for (int m = 0; m < 4; ++m)
#pragma unroll
                for (int n = 0; n < 2; ++n) acc[a][b][m][n] = (f32x4){0.f, 0.f, 0.f, 0.f};
    bf16x8 At[4][2], B0[2][2], B1[2][2];
    const char* cB = (const char*)g.Bt + (size_t)cur.g * g.bgroup + (size_t)cur.pn * tstep;
    if constexpr (SP2) {
        PG8_STAGE(PG8_SB(0, 0), cB, voffB); PG8_STAGE(PG8_SB(0, 1), cB + hstep, voffB); PG8_STAGE(PG8_SA(0, 0), A.tile(cur, 0, 0), A.voff(0)); PG8_STAGE(PG8_SA(0, 1), A.tile(cur, 1, 0), A.voff(0));
        if (wr == 1) PG8_BAR;
        WAIT_V(2); PG8_BAR;
        PG8_STAGE(PG8_SB(1, 0), cB + kstep, voffB); PG8_STAGE(PG8_SA(1, 0), A.tile(cur, 0, 1), A.voff(1)); PG8_STAGE(PG8_SB(1, 1), cB + hstep + kstep, voffB);
        WAIT_V(6); PG8_BAR;
    } else {
        PG8_STAGE(PG8_SB(0, 0), cB, voffB); PG8_STAGE(PG8_SA(0, 0), A.tile(cur, 0, 0), A.voff(0)); PG8_STAGE(PG8_SB(0, 1), cB + hstep, voffB); PG8_STAGE(PG8_SA(0, 1), A.tile(cur, 1, 0), A.voff(0));
        if (wr == 1) PG8_BAR;
        WAIT_V(4); PG8_BAR;
        PG8_STAGE(PG8_SB(1, 0), cB + kstep, voffB); PG8_STAGE(PG8_SA(1, 0), A.tile(cur, 0, 1), A.voff(1)); PG8_STAGE(PG8_SB(1, 1), cB + hstep + kstep, voffB);
        WAIT_V(6); PG8_BAR;
    }
    for (;;) {
        const bool has_next = S.next(ui + 1, nxt); nxt.ord = ui + 1;
        const Unit un = has_next ? nxt : cur;
        const char* nB = (const char*)g.Bt + (size_t)un.g * g.bgroup + (size_t)un.pn * tstep;
#pragma unroll 1
        for (int t = 0; t < nt; t += 2) {
            const bool last = (t == nt - 2);
            const Unit u2 = last ? un : cur; const int t2 = last ? 0 : t + 2;
            const char* b2 = last ? nB : cB + (size_t)(t + 2) * kstep; const char* b3 = b2 + kstep;
            if constexpr (SP2) {
            PG8_LDB(B0, 0, 0); PG8_LDB(B1, 0, 1); PG8_SCHED; PG8_LDA(At, 0, 0); PG8_STAGE(PG8_SA(1, 1), A.tile(cur, 1, t + 1), A.voff(t + 1));
            WAIT_V(8); WAIT_L(0); PG8_BAR; PG8_MMA(0, 0, At, B0); PG8_MMA(0, 1, At, B1); PG8_BAR; PG8_SCHED;
            PG8_LDA(At, 0, 1); PG8_STAGE(PG8_SB(0, 0), b2, voffB); PG8_STAGE(PG8_SB(0, 1), b2 + hstep, voffB); PG8_STAGE(PG8_SA(0, 0), A.tile(u2, 0, t2), A.voff(t2));
            WAIT_V(8); WAIT_L(0); PG8_BAR; PG8_MMA(1, 0, At, B0); PG8_MMA(1, 1, At, B1); PG8_BAR; PG8_SCHED;
            PG8_LDB(B0, 1, 0); PG8_LDB(B1, 1, 1); PG8_SCHED; PG8_LDA(At, 1, 0); PG8_STAGE(PG8_SA(0, 1), A.tile(u2, 1, t2), A.voff(t2));
            WAIT_V(8); WAIT_L(0); PG8_BAR; PG8_MMA(0, 0, At, B0); PG8_MMA(0, 1, At, B1); PG8_BAR; PG8_SCHED;
            PG8_LDA(At, 1, 1); PG8_STAGE(PG8_SB(1, 0), b3, voffB); PG8_STAGE(PG8_SB(1, 1), b3 + hstep, voffB); PG8_STAGE(PG8_SA(1, 0), A.tile(u2, 0, t2 + 1), A.voff(t2 + 1));
            WAIT_V(8); WAIT_L(0); PG8_BAR; PG8_MMA(1, 0, At, B0); PG8_MMA(1, 1, At, B1); PG8_BAR; PG8_SCHED;
            } else {
            PG8_LDB(B0, 0, 0); PG8_SCHED; PG8_LDA(At, 0, 0); PG8_STAGE(PG8_SA(1, 1), A.tile(cur, 1, t + 1), A.voff(t + 1));
            WAIT_L(8); PG8_BAR; WAIT_L(0); PG8_MMA(0, 0, At, B0); PG8_BAR; PG8_SCHED;
            PG8_LDB(B1, 0, 1); PG8_STAGE(PG8_SB(0, 0), b2, voffB);
            PG8_BAR; WAIT_L(0); PG8_MMA(0, 1, At, B1); PG8_BAR;
            PG8_LDA(At, 0, 1); PG8_STAGE(PG8_SA(0, 0), A.tile(u2, 0, t2), A.voff(t2));
            PG8_BAR; WAIT_L(0); PG8_MMA(1, 0, At, B0); PG8_BAR; PG8_SCHED;
            PG8_STAGE(PG8_SB(0, 1), b2 + hstep, voffB);
            WAIT_V(6); PG8_BAR; PG8_MMA(1, 1, At, B1); PG8_BAR;
            PG8_LDB(B0, 1, 0); PG8_SCHED; PG8_LDA(At, 1, 0); PG8_STAGE(PG8_SA(0, 1), A.tile(u2, 1, t2), A.voff(t2));
            WAIT_L(8); PG8_BAR; WAIT_L(0); PG8_MMA(0, 0, At, B0); PG8_BAR; PG8_SCHED;
            PG8_LDB(B1, 1, 1); PG8_STAGE(PG8_SB(1, 0), b3, voffB);
            PG8_BAR; WAIT_L(0); PG8_MMA(0, 1, At, B1); PG8_BAR;
            PG8_LDA(At, 1, 1); PG8_STAGE(PG8_SA(1, 0), A.tile(u2, 0, t2 + 1), A.voff(t2 + 1));
            PG8_BAR; WAIT_L(0); PG8_MMA(1, 0, At, B0); PG8_BAR; PG8_SCHED;
            PG8_STAGE(PG8_SB(1, 1), b3 + hstep, voffB);
            WAIT_V(6); PG8_BAR; PG8_MMA(1, 1, At, B1); PG8_BAR;
            }
        }
        if constexpr (ALIGN_EPI) { if (wr == 0) PG8_BAR; }
        E(acc, cur, wr, wc, fr, fq, !has_next);
        if (!has_next) break;
#pragma unroll
        for (int a = 0; a < 2; ++a)
#pragma unroll
            for (int b = 0; b < 2; ++b)
#pragma unroll
                for (int m = 0; m < 4; ++m)
#pragma unroll
                    for (int n = 0; n < 2; ++n) acc[a][b][m][n] = (f32x4){0.f, 0.f, 0.f, 0.f};
        cur = nxt; cB = nB; ++ui;
        if constexpr (ALIGN_EPI) { if (wr == 1) PG8_BAR; }
    }
    WAIT_V(0);
    if constexpr (!ALIGN_EPI) { if (wr == 0) PG8_BAR; }
    PG8_BAR;
#undef PG8_SA
#undef PG8_SB
#undef PG8_STAGE
#undef PG8_LDA
#undef PG8_LDB
#undef PG8_MMA
#undef PG8_BAR
#undef PG8_SCHED
}
}
using pg8::store16_wt; using pg8::store4_wt; using pg8::store4u_wt; using pg8::store8_wt;

#ifndef CPU_EMU
#define KAS __attribute__((address_space(4)))
#else
#define KAS
#endif
struct InPtrs { const KAS Params* q; DI const float* operator[](int k) const { return q->in[k]; } };
struct Frame {
    LAS unsigned char* lds; int tid, lane, wave, G; long gtid, gthreads; int gwave, gwaves;
    InPtrs in; float* out; unsigned char* ws;
};
#define WSP(type, off) ((type*)(F.ws + (off)))
#define XRES ((bf16_t*)F.out)

DI void p0_transpose_item(const float* W, int K, int Nsrc, int N, const float* scale, int split, int gap, bf16_t* WT, LAS float* scr, int item, int lane) {
    const int nblk = N / 32, kb = item / nblk, nb = item % nblk, k0 = 64 * kb, n0 = 32 * nb, s0 = n0 < split ? n0 : (n0 < N1 ? n0 + gap : split);
    float wv[32];
#pragma unroll
    for (int i = 0; i < 32; ++i) { const int kk = 2 * i + (lane >> 5); wv[i] = W[(size_t)(k0 + kk) * Nsrc + s0 + (lane & 31)] * (scale ? scale[k0 + kk] : 1.0f); }
#pragma unroll
    for (int i = 0; i < 32; ++i) { const int kk = 2 * i + (lane >> 5); scr[kk * 33 + (lane & 31)] = wv[i]; }
    WAIT_L(0); asm volatile("" ::: "memory");
    const int c = lane & 7;
#pragma unroll
    for (int j = 0; j < 4; ++j) { const int n = (lane >> 3) + 8 * j; const LAS float* s = scr + (8 * c) * 33 + n;
        u32x4 o; o.x = pk2(s[0 * 33], s[1 * 33]); o.y = pk2(s[2 * 33], s[3 * 33]); o.z = pk2(s[4 * 33], s[5 * 33]); o.w = pk2(s[6 * 33], s[7 * 33]);
        *(u32x4*)(WT + (size_t)(n0 + n) * K + k0 + 8 * c) = o; }
    WAIT_L(0); asm volatile("" ::: "memory");
}
DI void s5_lam(const InPtrs in, int g, int n, double& lre, double& lim, double& fre, double& fim) {
    const double are = in[19][g * 64 + n], aim = in[20][g * 64 + n], step = exp((double)in[21][g]);
    const double mag = exp(are * step); double sn, cs; sincos_rev(aim * step * 0.15915494309189533577, sn, cs); lre = mag * cs; lim = mag * sn;
    const double nre = lre - 1.0, nim = lim, den = are * are + aim * aim; fre = (nre * are + nim * aim) / den; fim = (nim * are - nre * aim) / den;
}
DI void p0_prologue(Frame& F) {
    LAS float* scr = (LAS float*)(F.lds + F.wave * 16384);
    constexpr int I_IN0 = (D / 64) * (N0 / 32), I_SQ = (D / 64) * (D / 32), I_UP = (D / 64) * (DFF / 32), I_DN = (DFF / 64) * (D / 32), I_IN1 = (D / 64) * (N1G / 32), I_WG = (256 / 64) * (256 / 32);
    constexpr int NITEMS = I_IN0 + I_IN1 + 2 * (I_SQ + I_UP + I_DN) + I_WG;
    for (int it = F.gwave; it < NITEMS; it += F.gwaves) {
        int r = it;
        if (r < I_IN0) { p0_transpose_item(F.in[2], D, N0SRC, N0, F.in[1], 1 << 30, 0, WSP(bf16_t, WS_W_IN0), scr, r, F.lane); continue; } r -= I_IN0;
        if (r < I_SQ) { p0_transpose_item(F.in[9], D, D, D, nullptr, 1 << 30, 0, WSP(bf16_t, WS_W_OUT0), scr, r, F.lane); continue; } r -= I_SQ;
        if (r < I_UP) { p0_transpose_item(F.in[11], D, DFF, DFF, F.in[10], 1 << 30, 0, WSP(bf16_t, WS_W_UP0), scr, r, F.lane); continue; } r -= I_UP;
        if (r < I_DN) { p0_transpose_item(F.in[12], DFF, D, D, nullptr, 1 << 30, 0, WSP(bf16_t, WS_W_DN0), scr, r, F.lane); continue; } r -= I_DN;
        if (r < I_IN1) { p0_transpose_item(F.in[14], D, N1SRC, N1G, F.in[13], 3072, 12, WSP(bf16_t, WS_W_IN1), scr, r, F.lane); continue; } r -= I_IN1;
        if (r < I_WG) { p0_transpose_item(F.in[27], 256, 256, 256, nullptr, 1 << 30, 0, WSP(bf16_t, WS_S5_WG), scr, r, F.lane); continue; } r -= I_WG;
        if (r < I_SQ) { p0_transpose_item(F.in[29], D, D, D, nullptr, 1 << 30, 0, WSP(bf16_t, WS_W_OUT1), scr, r, F.lane); continue; } r -= I_SQ;
        if (r < I_UP) { p0_transpose_item(F.in[31], D, DFF, DFF, F.in[30], 1 << 30, 0, WSP(bf16_t, WS_W_UP1), scr, r, F.lane); continue; } r -= I_UP;
        p0_transpose_item(F.in[32], DFF, D, D, nullptr, 1 << 30, 0, WSP(bf16_t, WS_W_DN1), scr, r, F.lane);
    }
    __syncthreads();
    LAS float* wdt = (LAS float*)F.lds;
    for (int i = F.tid; i < 1024 * 8; i += NTHREADS) { const int k = i >> 3, c = i & 7; wdt[i] = F.in[1][k] * F.in[2][(size_t)k * N0SRC + N0 + c]; }
    __syncthreads();
    f32x4 vnx[4];
    if (F.gwave < T) { const f32x4* xr = (const f32x4*)(F.in[0] + (size_t)F.gwave * D) + F.lane;
#pragma unroll
        for (int j = 0; j < 4; ++j) vnx[j] = xr[64 * j]; }
    for (int m = F.gwave; m < T; m += F.gwaves) {
        f32x4 v[4]; float s = 0.f;
#pragma unroll
        for (int j = 0; j < 4; ++j) { v[j] = vnx[j]; s += (v[j][0] * v[j][0] + v[j][1] * v[j][1]) + (v[j][2] * v[j][2] + v[j][3] * v[j][3]); }
        if (m + F.gwaves < T) { const f32x4* xr = (const f32x4*)(F.in[0] + (size_t)(m + F.gwaves) * D) + F.lane;
#pragma unroll
            for (int j = 0; j < 4; ++j) vnx[j] = xr[64 * j]; }
        const float rs = __builtin_amdgcn_rsqf(wave_sum(s) * (1.0f / D) + EPS);
        float dacc[8];
#pragma unroll
        for (int c = 0; c < 8; ++c) dacc[c] = 0.f;
        unsigned long long* o8 = (unsigned long long*)(WSP(bf16_t, WS_XN) + (size_t)m * D) + F.lane;
#pragma unroll
        for (int j = 0; j < 4; ++j) {
            v[j] = v[j] * rs;
            o8[64 * j] = (unsigned long long)pk2(v[j][0], v[j][1]) | ((unsigned long long)pk2(v[j][2], v[j][3]) << 32);
#pragma unroll
            for (int e = 0; e < 4; ++e) { const LAS f32x4* wp = (const LAS f32x4*)(wdt + (size_t)(4 * F.lane + 256 * j + e) * 8); const f32x4 w0 = wp[0], w1 = wp[1];
#pragma unroll
                for (int c = 0; c < 4; ++c) { dacc[c] += v[j][e] * w0[c]; dacc[4 + c] += v[j][e] * w1[c]; } }
        }
#pragma unroll
        for (int c = 0; c < 8; ++c) dacc[c] = wave_sum(dacc[c]);
        float mine = 0.f;
#pragma unroll
        for (int c = 0; c < 8; ++c) mine = (F.lane == c) ? dacc[c] : mine;
        if (F.lane < 8) WSP(float, WS_DT)[(size_t)m * 8 + F.lane] = softplus_f(mine + F.in[5][F.lane]);
    }
    for (long i = F.gtid; i < (long)L * 64; i += F.gthreads) {
        const int fi = (int)(i & 63), t = (int)(i >> 6);
        double inv = 1.0;
        if (fi & 1) inv *= 0.86596432336006535; if (fi & 2) inv *= 0.74989420933245582; if (fi & 4) inv *= 0.56234132519034908;
        if (fi & 8) inv *= 0.31622776601683794; if (fi & 16) inv *= 0.1; if (fi & 32) inv *= 0.01;
        double s, c; sincos_rev((double)t * inv * 0.15915494309189533577, s, c);
        WSP(f32x2, WS_ROPE)[i] = (f32x2){(float)c, (float)s};
    }
    bf16_t* MG = WSP(bf16_t, WS_S5_MG); bf16_t* HM = WSP(bf16_t, WS_S5_H);
    __syncthreads();
    LAS double* PWR = (LAS double*)F.lds; LAS double* PWI = PWR + 17 * 64; LAS double* FRE = PWI + 17 * 64; LAS double* FIM = FRE + 64;
    LAS float* BBR = (LAS float*)(FIM + 64); LAS float* BBI = BBR + 1024; LAS float* CRE = BBI + 1024; LAS float* CIM = CRE + 1024;
    auto build = [&](int g) { __syncthreads(); if (F.tid < 64) { double lre, lim, fre, fim; s5_lam(F.in, g, F.tid, lre, lim, fre, fim); FRE[F.tid] = fre; FIM[F.tid] = fim; double pre = 1.0, pim = 0.0;
            for (int k = 0; k <= 16; ++k) { PWR[k * 64 + F.tid] = pre; PWI[k * 64 + F.tid] = pim; const double t = pre * lre - pim * lim; pim = pre * lim + pim * lre; pre = t; }
            for (int c2 = 0; c2 < 16; ++c2) { const double bre = F.in[22][(g * 64 + F.tid) * 16 + c2], bim = F.in[23][(g * 64 + F.tid) * 16 + c2]; BBR[F.tid * 16 + c2] = (float)(fre * bre - fim * bim); BBI[F.tid * 16 + c2] = (float)(fre * bim + fim * bre); } }
        for (int k = F.tid; k < 1024; k += NTHREADS) { CRE[k] = F.in[24][g * 1024 + k]; CIM[k] = F.in[25][g * 1024 + k]; }
        __syncthreads(); };
    for (long base = (long)blockIdx.x * NTHREADS; base < 65536; base += F.gthreads) { const long i = base + F.tid; const int g = (int)(base >> 12); build(g);
        const int cp = (int)(i & 15), c = (int)((i >> 4) & 15), dl = (int)((i >> 8) & 15); double acc = 0.0;
        for (int n = 0; n < 64; ++n) { const double pre = PWR[dl * 64 + n], pim = PWI[dl * 64 + n], bbre = BBR[n * 16 + cp], bbim = BBI[n * 16 + cp];
            const double qre = pre * bbre - pim * bbim, qim = pre * bbim + pim * bbre; acc += (double)CRE[c * 64 + n] * qre - (double)CIM[c * 64 + n] * qim; }
        if (dl == 0 && c == cp) acc += (double)F.in[26][g * 16 + c];
        const bf16_t v = f2bf((float)acc);
        for (int l = dl; l < 16; ++l) MG[((size_t)g * 256 + l * 16 + c) * 384 + (l - dl) * 16 + cp] = v;
    }
    for (long i = F.gtid; i < 16L * 256 * 256; i += F.gthreads) { const int col = (int)(i & 255), row = (int)((i >> 8) & 255), g = (int)(i >> 16);
        if ((col >> 4) > (row >> 4)) MG[((size_t)g * 256 + row) * 384 + col] = 0;
        if (row >= 128) HM[((size_t)g * 256 + row) * 256 + col] = 0; }
    for (long base = (long)blockIdx.x * NTHREADS; base < 16L * 256 * 64; base += F.gthreads) { const long i = base + F.tid; const int g = (int)(base >> 14); build(g);
        const int n = (int)(i & 63), row = (int)((i >> 6) & 255), l = row >> 4, c = row & 15; const double pre = PWR[(l + 1) * 64 + n], pim = PWI[(l + 1) * 64 + n];
        const double cre = F.in[24][(g * 16 + c) * 64 + n], cim = F.in[25][(g * 16 + c) * 64 + n];
        MG[((size_t)g * 256 + row) * 384 + 256 + n] = f2bf((float)(cre * pre - cim * pim)); MG[((size_t)g * 256 + row) * 384 + 320 + n] = f2bf((float)(-(cre * pim + cim * pre))); }
    for (long base = (long)blockIdx.x * NTHREADS; base < 16L * 64 * 256; base += F.gthreads) { const long i = base + F.tid; const int g = (int)(base >> 14); build(g);
        const int col = (int)(i & 255), n = (int)((i >> 8) & 63), sidx = col >> 4, cp = col & 15; const double pre = PWR[(15 - sidx) * 64 + n], pim = PWI[(15 - sidx) * 64 + n], fre = FRE[n], fim = FIM[n];
        const double bre = F.in[22][(g * 64 + n) * 16 + cp], bim = F.in[23][(g * 64 + n) * 16 + cp]; const double bbre = fre * bre - fim * bim, bbim = fre * bim + fim * bre;
        HM[((size_t)g * 256 + n) * 256 + col] = f2bf((float)(pre * bbre - pim * bbim)); HM[((size_t)g * 256 + 64 + n) * 256 + col] = f2bf((float)(pre * bbim + pim * bbre)); }
}

#define P0B WSP(bf16_t, WS_PROJ)
#define XBC WSP(bf16_t, WS_XN)
#define SCB WSP(float, WS_TAIL)
#define CBB WSP(float, WS_PROJ + (size_t)T * N0 * 2)
#define YRS (F.out)
DI float ret_log_gamma(int h) { return logf(1.0f - exp2f(-5.0f - (float)h)); }

DI void l0_level_a(Frame& F) {
    const f32x2* rope = WSP(f32x2, WS_ROPE);
    for (long idx = F.gtid; idx < (long)T * 512; idx += F.gthreads) {
        const int i = (int)(idx & 63), h = (int)((idx >> 6) & 3), which = (int)((idx >> 8) & 1); const long tok = idx >> 9; const int t = (int)(tok % L);
        bf16_t* p = P0B + (size_t)tok * N0 + which * 512 + h * 128 + i;
        const float x1 = bf2f(p[0]), x2 = bf2f(p[64]); const f32x2 cs = rope[(size_t)t * 64 + i]; const float sc = which == 0 ? 0.08838834764831845f : 1.0f;
        p[0] = f2bf((x1 * cs[0] - x2 * cs[1]) * sc); p[64] = f2bf((x1 * cs[1] + x2 * cs[0]) * sc);
    }
    for (long idx = F.gtid; idx < (long)T * 1024; idx += F.gthreads) {
        const int c = (int)(idx & 1023); const long tok = idx >> 10; const int t = (int)(tok % L);
        float a = F.in[4][c];
#pragma unroll
        for (int j = 0; j < 4; ++j) if (t - 3 + j >= 0) a += F.in[3][j * 1024 + c] * bf2f(P0B[(size_t)(tok - 3 + j) * N0 + 2560 + c]);
        XBC[(size_t)tok * 1024 + c] = f2bf(silu_f(a));
    }
    for (long idx = F.gtid; idx < (long)NCHT * 8; idx += F.gthreads) {
        const int h = (int)(idx & 7); const long ch = idx >> 3; const float a = -expf(F.in[6][h]); float run = 0.f;
        for (int l = 0; l < 64; ++l) { const size_t tok = (size_t)ch * 64 + l; run += WSP(float, WS_DT)[tok * 8 + h] * a; WSP(float, WS_LAC)[tok * 8 + h] = run; }
    }
}
DI void l0_level_b(Frame& F) {
    for (long idx = F.gtid; idx < (long)NCHT * 4 * 4096; idx += F.gthreads) {
        const int s = (int)(idx & 63), l = (int)((idx >> 6) & 63), h = (int)((idx >> 12) & 3); const long ch = idx >> 14;
        float v = 0.f;
        if (s <= l) { const bf16_t* q = P0B + (size_t)(ch * 64 + l) * N0 + h * 128; const bf16_t* k = P0B + (size_t)(ch * 64 + s) * N0 + 512 + h * 128;
            for (int d = 0; d < 128; ++d) v += bf2f(q[d]) * bf2f(k[d]);
            v *= expf(ret_log_gamma(h) * (float)(l - s)); }
        SCB[idx] = v;
    }
    for (long idx = F.gtid; idx < (long)NCHT * 2 * 4096; idx += F.gthreads) {
        const int s = (int)(idx & 63), l = (int)((idx >> 6) & 63), g = (int)((idx >> 12) & 1); const long ch = idx >> 13;
        float v = 0.f;
        if (s <= l) { const bf16_t* c = XBC + (size_t)(ch * 64 + l) * 1024 + 768 + g * 128; const bf16_t* b = XBC + (size_t)(ch * 64 + s) * 1024 + 512 + g * 128;
            for (int n = 0; n < 128; ++n) v += bf2f(c[n]) * bf2f(b[n]); }
        CBB[idx] = v;
    }
}
DI void l0_level_c(Frame& F) {
    for (long idx = F.gtid; idx < (long)T * 512; idx += F.gthreads) {
        const int e = (int)(idx & 127), h = (int)((idx >> 7) & 3); const long tok = idx >> 9, ch = tok >> 6; const int l = (int)(tok & 63);
        const float* sc = SCB + ((size_t)(ch * 4 + h) * 64 + l) * 64; float y = 0.f;
        for (int s = 0; s <= l; ++s) y += sc[s] * bf2f(P0B[(size_t)(ch * 64 + s) * N0 + 1024 + h * 128 + e]);
        YRS[(size_t)tok * 1024 + h * 128 + e] = y;
    }
    for (long idx = F.gtid; idx < (long)T * 512; idx += F.gthreads) {
        const int p = (int)(idx & 63), h = (int)((idx >> 6) & 7), g = h >> 2; const long tok = idx >> 9, ch = tok >> 6; const int l = (int)(tok & 63);
        const float* cb = CBB + ((size_t)(ch * 2 + g) * 64 + l) * 64; const float lal = WSP(float, WS_LAC)[(size_t)tok * 8 + h]; float y = 0.f;
        for (int s = 0; s <= l; ++s) { const size_t ts = (size_t)ch * 64 + s;
            y += cb[s] * expf(lal - WSP(float, WS_LAC)[ts * 8 + h]) * bf2f(XBC[ts * 1024 + h * 64 + p]) * WSP(float, WS_DT)[ts * 8 + h]; }
        YRS[(size_t)tok * 1024 + 512 + h * 64 + p] = y;
    }
}
DI void l0_level_d(Frame& F) {
    if (F.gtid < 1024) {
        const int e = (int)(F.gtid & 127), h = (int)((F.gtid >> 7) & 3), b = (int)(F.gtid >> 9);
        const float lg = ret_log_gamma(h), g64 = expf(lg * 64.0f);
        float S[128];
#pragma unroll
        for (int d = 0; d < 128; ++d) S[d] = 0.f;
#pragma unroll 1
        for (int c = 0; c < L / 64; ++c) {
#pragma unroll 1
            for (int l = 0; l < 64; ++l) { const size_t tok = (size_t)b * L + c * 64 + l; const u32x4* q = (const u32x4*)(P0B + tok * N0 + h * 128); float a = 0.f;
#pragma unroll
                for (int d8 = 0; d8 < 16; ++d8) { const u32x4 w = q[d8];
#pragma unroll
                    for (int j = 0; j < 4; ++j) { a += __uint_as_float(w[j] << 16) * S[d8 * 8 + 2 * j]; a += __uint_as_float(w[j] & 0xffff0000u) * S[d8 * 8 + 2 * j + 1]; } }
                YRS[tok * 1024 + h * 128 + e] += a * expf(lg * (float)(l + 1)); }
#pragma unroll
            for (int d = 0; d < 128; ++d) S[d] *= g64;
#pragma unroll 1
            for (int l = 0; l < 64; ++l) { const size_t tok = (size_t)b * L + c * 64 + l; const u32x4* k = (const u32x4*)(P0B + tok * N0 + 512 + h * 128);
                const float vv = bf2f(P0B[tok * N0 + 1024 + h * 128 + e]) * expf(lg * (float)(63 - l));
#pragma unroll
                for (int d8 = 0; d8 < 16; ++d8) { const u32x4 w = k[d8];
#pragma unroll
                    for (int j = 0; j < 4; ++j) { S[d8 * 8 + 2 * j] += __uint_as_float(w[j] << 16) * vv; S[d8 * 8 + 2 * j + 1] += __uint_as_float(w[j] & 0xffff0000u) * vv; } } }
        }
    } else if (F.gtid < 2048) {
        const int id = (int)(F.gtid - 1024), p = id & 63, h = (id >> 6) & 7, b = id >> 9, g = h >> 2;
        float S[128];
#pragma unroll
        for (int n = 0; n < 128; ++n) S[n] = 0.f;
#pragma unroll 1
        for (int c = 0; c < L / 64; ++c) {
            const size_t tok0 = (size_t)b * L + c * 64; const float lalast = WSP(float, WS_LAC)[(tok0 + 63) * 8 + h];
#pragma unroll 1
            for (int l = 0; l < 64; ++l) { const size_t tok = tok0 + l; const u32x4* cc = (const u32x4*)(XBC + tok * 1024 + 768 + g * 128); float a = 0.f;
#pragma unroll
                for (int d8 = 0; d8 < 16; ++d8) { const u32x4 w = cc[d8];
#pragma unroll
                    for (int j = 0; j < 4; ++j) { a += __uint_as_float(w[j] << 16) * S[d8 * 8 + 2 * j]; a += __uint_as_float(w[j] & 0xffff0000u) * S[d8 * 8 + 2 * j + 1]; } }
                YRS[tok * 1024 + 512 + h * 64 + p] += a * expf(WSP(float, WS_LAC)[tok * 8 + h]); }
            const float cd = expf(lalast);
#pragma unroll
            for (int n = 0; n < 128; ++n) S[n] *= cd;
#pragma unroll 1
            for (int l = 0; l < 64; ++l) { const size_t tok = tok0 + l; const u32x4* bb = (const u32x4*)(XBC + tok * 1024 + 512 + g * 128);
                const float vv = bf2f(XBC[tok * 1024 + h * 64 + p]) * WSP(float, WS_DT)[tok * 8 + h] * expf(lalast - WSP(float, WS_LAC)[tok * 8 + h]);
#pragma unroll
                for (int d8 = 0; d8 < 16; ++d8) { const u32x4 w = bb[d8];
#pragma unroll
                    for (int j = 0; j < 4; ++j) { S[d8 * 8 + 2 * j] += __uint_as_float(w[j] << 16) * vv; S[d8 * 8 + 2 * j + 1] += __uint_as_float(w[j] & 0xffff0000u) * vv; } } }
        }
    }
}
DI void l0_level_e(Frame& F) {
    bf16_t* mix = WSP(bf16_t, WS_MIX);
    for (long idx = F.gtid; idx < (long)T * 4; idx += F.gthreads) {
        const int h = (int)(idx & 3); const size_t tok = (size_t)(idx >> 2); const float* y = YRS + tok * 1024 + h * 128; float ss = 0.f;
        for (int e = 0; e < 128; ++e) ss += y[e] * y[e];
        const float r = 1.0f / sqrtf(ss * (1.0f / 128.0f) + EPS);
        for (int e = 0; e < 128; ++e) mix[tok * 1024 + h * 128 + e] = f2bf(silu_f(bf2f(P0B[tok * N0 + 1536 + h * 128 + e])) * y[e] * r);
    }
    for (long idx = F.gtid; idx < (long)T * 2; idx += F.gthreads) {
        const int g = (int)(idx & 1); const size_t tok = (size_t)(idx >> 1); float ss = 0.f;
        for (int j = 0; j < 256; ++j) { const int ch = g * 256 + j; const float y = (YRS[tok * 1024 + 512 + ch] + F.in[7][ch >> 6] * bf2f(XBC[tok * 1024 + ch])) * silu_f(bf2f(P0B[tok * N0 + 2048 + ch])); ss += y * y; }
        const float r = 1.0f / sqrtf(ss * (1.0f / 256.0f) + EPS);
        for (int j = 0; j < 256; ++j) { const int ch = g * 256 + j; const float y = (YRS[tok * 1024 + 512 + ch] + F.in[7][ch >> 6] * bf2f(XBC[tok * 1024 + ch])) * silu_f(bf2f(P0B[tok * N0 + 2048 + ch]));
            mix[tok * 1024 + 512 + ch] = f2bf(y * r * F.in[8][ch]); }
    }
}


DI float bflo(unsigned w) { return __uint_as_float(w << 16); }
DI float bfhi(unsigned w) { return __uint_as_float(w & 0xffff0000u); }
DI float u4elem(const u32x4 v, int c) { const unsigned w = (c >> 1) == 0 ? v.x : (c >> 1) == 1 ? v.y : (c >> 1) == 2 ? v.z : v.w; return (c & 1) ? bfhi(w) : bflo(w); }
DI void conv_oct_weights(const float* w, int wpitch, const float* bias, f32x4 (&wl)[4][2], f32x4 (&bl)[2]) {
#pragma unroll
    for (int t = 0; t < 4; ++t) { wl[t][0] = *(const f32x4*)(w + t * wpitch); wl[t][1] = *(const f32x4*)(w + t * wpitch + 4); }
    bl[0] = (f32x4){0.f, 0.f, 0.f, 0.f}; bl[1] = bl[0];
    if (bias) { bl[0] = *(const f32x4*)bias; bl[1] = *(const f32x4*)(bias + 4); }
}
DI void conv_oct_apply(const u32x4 (&x)[11], const f32x4 (&wl)[4][2], const f32x4 (&bl)[2], u32x4 (&yr)[8]) {
#pragma unroll
    for (int q4 = 0; q4 < 4; ++q4) {
        const int hf = q4 & 1, r0 = 4 * (q4 >> 1);
#pragma unroll
        for (int r = r0; r < r0 + 4; ++r) { float a[4];
#pragma unroll
            for (int c = 0; c < 4; ++c) { float v = bl[hf][c];
#pragma unroll
                for (int t = 0; t < 4; ++t) { const unsigned wv = hf == 0 ? (c < 2 ? x[r + t].x : x[r + t].y) : (c < 2 ? x[r + t].z : x[r + t].w); v += wl[t][hf][c] * ((c & 1) ? bfhi(wv) : bflo(wv)); }
                a[c] = silu_fast(v); }
            if (hf == 0) { yr[r].x = pk2(a[0], a[1]); yr[r].y = pk2(a[2], a[3]); } else { yr[r].z = pk2(a[0], a[1]); yr[r].w = pk2(a[2], a[3]); } }
        __builtin_amdgcn_sched_barrier(0);
    }
}
DI void conv_oct(const bf16_t* src, size_t pitch, int tfirst, const float* w, int wpitch, const float* bias, u32x4 (&yr)[8]) {
    u32x4 x[11];
#pragma unroll
    for (int j = 0; j < 11; ++j) { x[j] = (u32x4){0u, 0u, 0u, 0u}; if (tfirst + j >= 0) x[j] = *(const u32x4*)(src + (size_t)j * pitch); }
    f32x4 wl[4][2], bl[2]; conv_oct_weights(w, wpitch, bias, wl, bl); conv_oct_apply(x, wl, bl, yr);
}
DI unsigned u4half(const u32x4 v, int c) { const unsigned w = (c >> 1) == 0 ? v.x : (c >> 1) == 1 ? v.y : (c >> 1) == 2 ? v.z : v.w; return (c & 1) ? (w >> 16) : (w & 0xffffu); }
DI u32x4 pack_col(const u32x4 (&yr)[8], int c) { u32x4 o; o.x = u4half(yr[0], c) | (u4half(yr[1], c) << 16); o.y = u4half(yr[2], c) | (u4half(yr[3], c) << 16);
    o.z = u4half(yr[4], c) | (u4half(yr[5], c) << 16); o.w = u4half(yr[6], c) | (u4half(yr[7], c) << 16); return o; }
DI void transpose_oct(const bf16_t* src, size_t pitch, LAS bf16_t* dst, int dpitch, int c0, int l0) {
    u32x4 x[8];
#pragma unroll
    for (int j = 0; j < 8; ++j) x[j] = *(const u32x4*)(src + (size_t)j * pitch);
#pragma unroll
    for (int c = 0; c < 8; ++c) { u32x4 o; const int wi = c >> 1; unsigned e[8];
#pragma unroll
        for (int j = 0; j < 8; ++j) { const unsigned wv = wi == 0 ? x[j].x : wi == 1 ? x[j].y : wi == 2 ? x[j].z : x[j].w; e[j] = (c & 1) ? (wv >> 16) : (wv & 0xffffu); }
        o.x = e[0] | (e[1] << 16); o.y = e[2] | (e[3] << 16); o.z = e[4] | (e[5] << 16); o.w = e[6] | (e[7] << 16);
        *(LAS u32x4*)(dst + (c0 + c) * dpitch + l0) = o; }
}

constexpr int L0_UNITS = NCHT * 6;
#define L0_RS ((bf16_t*)F.out)
#define L0_SS ((bf16_t*)F.out + (size_t)NCHT * 65536)
#define L0_CDS WSP(float, WS_LAC)
#define L0_QKR WSP(bf16_t, WS_XN)
DI float ret_gamma_log2(int h) { return log2f(1.0f - exp2f(-5.0f - (float)h)); }

template <class Put> DI void ssd_conv_pair(Frame& F, long tok0, int t0, int xc, int l0, const Put& put) {
    const bf16_t* P = WSP(bf16_t, WS_PROJ) + 2560 + xc; float wa[4], wb[4];
#pragma unroll
    for (int j = 0; j < 4; ++j) { wa[j] = F.in[3][j * 1024 + xc]; wb[j] = F.in[3][j * 1024 + xc + 1]; }
    const float ba = F.in[4][xc], bb = F.in[4][xc + 1]; float xa[3], xb[3];
#pragma unroll
    for (int j = 0; j < 3; ++j) { const int l = l0 - 3 + j; unsigned v = 0u; if (t0 + l >= 0) v = *(const unsigned*)(P + (size_t)(tok0 + l) * N0); xa[j] = __uint_as_float(v << 16); xb[j] = __uint_as_float(v & 0xffff0000u); }
#pragma unroll 4
    for (int l = l0; l < l0 + 32; ++l) { const unsigned v = *(const unsigned*)(P + (size_t)(tok0 + l) * N0); const float ca = __uint_as_float(v << 16), cb = __uint_as_float(v & 0xffff0000u);
        const float ya = silu_f(ba + wa[0] * xa[0] + wa[1] * xa[1] + wa[2] * xa[2] + wa[3] * ca), yb = silu_f(bb + wb[0] * xb[0] + wb[1] * xb[1] + wb[2] * xb[2] + wb[3] * cb);
        xa[0] = xa[1]; xa[1] = xa[2]; xa[2] = ca; xb[0] = xb[1]; xb[1] = xb[2]; xb[2] = cb; put(l, ya, yb); }
}
DI void ssd_lacum_v(Frame& F, int g, int lane, const float (&dtv)[4], LAS float* LC, LAS float* DTL) {
#pragma unroll
    for (int hh = 0; hh < 4; ++hh) { const int h = 4 * g + hh; const float dt = dtv[hh]; float x = dt * -expf(F.in[6][h]);
#pragma unroll
        for (int o = 1; o < 64; o <<= 1) { const float t = __shfl_up(x, o); if (lane >= o) x += t; }
        LC[hh * 64 + lane] = x; DTL[hh * 64 + lane] = dt; }
}
DI void ssd_lacum(Frame& F, long tok0, int g, int lane, LAS float* LC, LAS float* DTL) {
#pragma unroll
    for (int hh = 0; hh < 4; ++hh) { const int h = 4 * g + hh; const float dt = WSP(float, WS_DT)[(size_t)(tok0 + lane) * 8 + h]; float x = dt * -expf(F.in[6][h]);
#pragma unroll
        for (int o = 1; o < 64; o <<= 1) { const float t = __shfl_up(x, o); if (lane >= o) x += t; }
        LC[hh * 64 + lane] = x; DTL[hh * 64 + lane] = dt; }
}

DI void l0_phase_a(Frame& F) {
    LAS unsigned char* lds = F.lds; const int w = F.wave;
    LAS bf16_t* AT_ = (LAS bf16_t*)lds;
    LAS bf16_t* BT_ = (LAS bf16_t*)(lds + 18432);
    LAS float* LC = (LAS float*)(lds + 18432 + 36864);
    LAS float* DTL = LC + 256;
    bf16_t* P0 = WSP(bf16_t, WS_PROJ); const f32x2* rope = WSP(f32x2, WS_ROPE);
    for (int u = blockIdx.x; u < L0_UNITS; u += F.G) {
        int tid = F.tid; OPAQUE_V(tid); const int lane = tid & 63, fr = lane & 15, fq = lane >> 4;
        const int ch = u / 6, sub = u % 6; const long tok0 = (long)ch * 64; const int t0 = (int)(tok0 % L);
        const bool lastu = u + 3 * F.G >= L0_UNITS;
        if (sub < 4) {
            const int h = sub; const float lg2 = ret_gamma_log2(h);
            {
                const int io = tid & 7, l = tid >> 3; const bf16_t* sq = P0 + (size_t)(tok0 + l) * N0 + h * 128 + 8 * io; const bf16_t* sk = sq + 512; bf16_t* pq = L0_QKR + (size_t)(tok0 + l) * 1024 + h * 128 + 8 * io; bf16_t* pk = pq + 512;
                const u32x4 q1 = *(const u32x4*)sq, q2 = *(const u32x4*)(sq + 64), k1 = *(const u32x4*)sk, k2 = *(const u32x4*)(sk + 64);
                const f32x4* rp = (const f32x4*)(rope + (size_t)(t0 + l) * 64 + 8 * io); const f32x4 r0 = rp[0], r1 = rp[1], r2 = rp[2], r3 = rp[3];
                const float cs[16] = {r0[0], r0[1], r0[2], r0[3], r1[0], r1[1], r1[2], r1[3], r2[0], r2[1], r2[2], r2[3], r3[0], r3[1], r3[2], r3[3]};
                float oq1[8], oq2[8], ok1[8], ok2[8];
#pragma unroll
                for (int c = 0; c < 8; ++c) { const float co = cs[2 * c], si = cs[2 * c + 1]; const float a1 = u4elem(q1, c), a2 = u4elem(q2, c), b1 = u4elem(k1, c), b2 = u4elem(k2, c);
                    oq1[c] = (a1 * co - a2 * si) * 0.08838834764831845f; oq2[c] = (a1 * si + a2 * co) * 0.08838834764831845f; ok1[c] = b1 * co - b2 * si; ok2[c] = b1 * si + b2 * co; }
                u32x4 w; w.x = pk2(oq1[0], oq1[1]); w.y = pk2(oq1[2], oq1[3]); w.z = pk2(oq1[4], oq1[5]); w.w = pk2(oq1[6], oq1[7]); if (lastu) store16_wt(pq, w); else *(u32x4*)pq = w;
                w.x = pk2(oq2[0], oq2[1]); w.y = pk2(oq2[2], oq2[3]); w.z = pk2(oq2[4], oq2[5]); w.w = pk2(oq2[6], oq2[7]); if (lastu) store16_wt(pq + 64, w); else *(u32x4*)(pq + 64) = w;
                w.x = pk2(ok1[0], ok1[1]); w.y = pk2(ok1[2], ok1[3]); w.z = pk2(ok1[4], ok1[5]); w.w = pk2(ok1[6], ok1[7]); if (lastu) store16_wt(pk, w); else *(u32x4*)pk = w;
                w.x = pk2(ok2[0], ok2[1]); w.y = pk2(ok2[2], ok2[3]); w.z = pk2(ok2[4], ok2[5]); w.w = pk2(ok2[6], ok2[7]); if (lastu) store16_wt(pk + 64, w); else *(u32x4*)(pk + 64) = w;
                const float kw = __builtin_amdgcn_exp2f(lg2 * (float)(63 - l));
#pragma unroll
                for (int c = 0; c < 8; ++c) { const int ls = (((l >> 3) ^ io) << 3) | (l & 7);
                    AT_[(8 * io + c) * 72 + ls] = f2bf(bf2f(f2bf(ok1[c])) * kw); AT_[(64 + 8 * io + c) * 72 + ls] = f2bf(bf2f(f2bf(ok2[c])) * kw); }
            }
            if (tid < 128) { const int eo = tid & 15, rg = tid >> 4; transpose_oct(P0 + (size_t)(tok0 + 8 * rg) * N0 + 1024 + h * 128 + 8 * eo, N0, BT_, 72, 8 * eo, 8 * rg); }
            __syncthreads();
            {
                const int sw = (2 * w + (fr >> 3)) & 7;
                const bf16x8 a0 = ldsfrag(AT_, 16 * w + fr, 8 * (fq ^ sw), 72), a1 = ldsfrag(AT_, 16 * w + fr, 8 * ((4 + fq) ^ sw), 72);
                bf16_t* rs = L0_RS + ((size_t)ch * 4 + h) * 16384;
                bf16x8 bfr[8][2];
#pragma unroll
                for (int n = 0; n < 8; ++n) { bfr[n][0] = ldsfrag(BT_, 16 * n + fr, 8 * fq, 72); bfr[n][1] = ldsfrag(BT_, 16 * n + fr, 32 + 8 * fq, 72); }
                __builtin_amdgcn_sched_barrier(0);
#pragma unroll
                for (int n = 0; n < 8; ++n) { f32x4 acc = {0.f, 0.f, 0.f, 0.f};
                    acc = __builtin_amdgcn_mfma_f32_16x16x32_bf16(a0, bfr[n][0], acc, 0, 0, 0);
                    acc = __builtin_amdgcn_mfma_f32_16x16x32_bf16(a1, bfr[n][1], acc, 0, 0, 0);
                    u32x2 o; o.x = cvt_pk_bf16(acc[0], acc[1]); o.y = cvt_pk_bf16(acc[2], acc[3]); *(u32x2*)(rs + (size_t)(16 * n + fr) * 128 + 16 * w + 4 * fq) = o; }
            }
            __syncthreads();
        } else {
            const int g = sub - 4;
            if (w == 7) ssd_lacum(F, tok0, g, lane, LC, DTL);
            __syncthreads();
            if (tid < 384) { const int oc = tid % 48, rg = tid / 48, c0 = 8 * oc, l0 = 8 * rg; u32x4 y[8];
                const int xc = c0 < 256 ? 256 * g + c0 : 512 + 128 * g + c0 - 256;
                conv_oct(WSP(bf16_t, WS_PROJ) + (size_t)(tok0 + l0 - 3) * N0 + 2560 + xc, N0, t0 + l0 - 3, F.in[3] + xc, 1024, F.in[4] + xc, y);
                if (c0 < 256) { const int hh = c0 >> 6; const float lal = LC[hh * 64 + 63]; float sc[8];
#pragma unroll
                    for (int r = 0; r < 8; ++r) sc[r] = DTL[hh * 64 + l0 + r] * __expf(lal - LC[hh * 64 + l0 + r]);
#pragma unroll
                    for (int c = 0; c < 8; ++c) { u32x4 o; o.x = pk2(u4elem(y[0], c) * sc[0], u4elem(y[1], c) * sc[1]); o.y = pk2(u4elem(y[2], c) * sc[2], u4elem(y[3], c) * sc[3]); o.z = pk2(u4elem(y[4], c) * sc[4], u4elem(y[5], c) * sc[5]); o.w = pk2(u4elem(y[6], c) * sc[6], u4elem(y[7], c) * sc[7]);
                        *(LAS u32x4*)(BT_ + (c0 + c) * 72 + ((rg ^ (oc & 7)) << 3)) = o; }
                } else { const int n0 = c0 - 256;
#pragma unroll
                    for (int c = 0; c < 8; ++c) *(LAS u32x4*)(AT_ + (n0 + c) * 72 + ((rg ^ (oc & 7)) << 3)) = pack_col(y, c); }
            } else if (tid < 388) { const int hh = tid - 384; L0_CDS[(size_t)ch * 8 + 4 * g + hh] = expf(LC[hh * 64 + 63]); }
            __syncthreads();
            {
                const int swa = (2 * w + (fr >> 3)) & 7;
                const bf16x8 a0 = ldsfrag(AT_, 16 * w + fr, 8 * (fq ^ swa), 72), a1 = ldsfrag(AT_, 16 * w + fr, 8 * ((4 + fq) ^ swa), 72);
#pragma unroll 1
                for (int c4 = 0; c4 < 4; ++c4) { bf16x8 bfr[4][2];
#pragma unroll
                    for (int q = 0; q < 4; ++q) { const int swb = (2 * q + (fr >> 3)) & 7; bfr[q][0] = ldsfrag(BT_, 16 * (4 * c4 + q) + fr, 8 * (fq ^ swb), 72); bfr[q][1] = ldsfrag(BT_, 16 * (4 * c4 + q) + fr, 8 * ((4 + fq) ^ swb), 72); }
                    __builtin_amdgcn_sched_barrier(0);
#pragma unroll
                    for (int q = 0; q < 4; ++q) { f32x4 acc = {0.f, 0.f, 0.f, 0.f};
                        acc = __builtin_amdgcn_mfma_f32_16x16x32_bf16(a0, bfr[q][0], acc, 0, 0, 0);
                        acc = __builtin_amdgcn_mfma_f32_16x16x32_bf16(a1, bfr[q][1], acc, 0, 0, 0);
                        u32x2 o; o.x = cvt_pk_bf16(acc[0], acc[1]); o.y = cvt_pk_bf16(acc[2], acc[3]);
                        *(u32x2*)(L0_SS + (((size_t)ch * 8 + 4 * g + c4) * 64 + 16 * q + fr) * 128 + 16 * w + 4 * fq) = o; } }
            }
            __syncthreads();
        }
    }
}
DI void l0_phase_b(Frame& F) {
    constexpr int NC = L / 64, NB = NC < 32 ? (NC < 16 ? NC / 2 : 8) : 16; static_assert(NB >= 1 && NC % (2 * NB) == 0, "phase b batches");
    for (long id = F.gtid; id < 2L * 65536; id += F.gthreads) {
        const int b = (int)(id >> 16), e = (int)(id & 65535); float s0 = 0.f, s1 = 0.f;
        if (e < 32768) { const int h = e >> 13; const float dec = exp2f(ret_gamma_log2(h) * 64.0f); unsigned* p = (unsigned*)L0_RS + (size_t)b * NC * 32768 + e; unsigned v[NB], w[NB];
#pragma unroll
            for (int k = 0; k < NB; ++k) v[k] = p[(size_t)k * 32768];
#pragma unroll 1
            for (int c = 0; c < NC; c += 2 * NB) {
#pragma unroll
                for (int k = 0; k < NB; ++k) w[k] = p[(size_t)(c + NB + k) * 32768];
#pragma unroll
                for (int k = 0; k < NB; ++k) { store4u_wt(p + (size_t)(c + k) * 32768, pk2(s0, s1)); s0 = s0 * dec + __uint_as_float(v[k] << 16); s1 = s1 * dec + __uint_as_float(v[k] & 0xffff0000u); }
                if (c + 2 * NB < NC) {
#pragma unroll
                    for (int k = 0; k < NB; ++k) v[k] = p[(size_t)(c + 2 * NB + k) * 32768]; }
#pragma unroll
                for (int k = 0; k < NB; ++k) { store4u_wt(p + (size_t)(c + NB + k) * 32768, pk2(s0, s1)); s0 = s0 * dec + __uint_as_float(w[k] << 16); s1 = s1 * dec + __uint_as_float(w[k] & 0xffff0000u); } }
        } else { const int e2 = e - 32768, h = e2 >> 12; unsigned* p = (unsigned*)L0_SS + (size_t)b * NC * 32768 + e2; const float* cd = L0_CDS + (size_t)b * NC * 8 + h; unsigned v[NB], w[NB]; float dv[NB], dw[NB];
#pragma unroll
            for (int k = 0; k < NB; ++k) { v[k] = p[(size_t)k * 32768]; dv[k] = cd[k * 8]; }
#pragma unroll 1
            for (int c = 0; c < NC; c += 2 * NB) {
#pragma unroll
                for (int k = 0; k < NB; ++k) { w[k] = p[(size_t)(c + NB + k) * 32768]; dw[k] = cd[(c + NB + k) * 8]; }
#pragma unroll
                for (int k = 0; k < NB; ++k) { store4u_wt(p + (size_t)(c + k) * 32768, pk2(s0, s1)); s0 = s0 * dv[k] + __uint_as_float(v[k] << 16); s1 = s1 * dv[k] + __uint_as_float(v[k] & 0xffff0000u); }
                if (c + 2 * NB < NC) {
#pragma unroll
                    for (int k = 0; k < NB; ++k) { v[k] = p[(size_t)(c + 2 * NB + k) * 32768]; dv[k] = cd[(c + 2 * NB + k) * 8]; } }
#pragma unroll
                for (int k = 0; k < NB; ++k) { store4u_wt(p + (size_t)(c + NB + k) * 32768, pk2(s0, s1)); s0 = s0 * dw[k] + __uint_as_float(w[k] << 16); s1 = s1 * dw[k] + __uint_as_float(w[k] & 0xffff0000u); } }
        }
    }
}
struct RetPf { u32x4 qk[4], kv[4]; unsigned vv[8]; };
DI void ret_issue(Frame& F, int ur, int tid, RetPf& r) {
    const int ch = ur >> 2, h = ur & 3; const size_t tok0 = (size_t)ch * 64; const bf16_t* P0 = WSP(bf16_t, WS_PROJ);
#pragma unroll
    for (int j = 0; j < 4; ++j) { const int it = tid + NTHREADS * j, c16 = it & 15, l = (it >> 4) & 63, which = it >> 10;
        r.qk[j] = *(const u32x4*)(L0_QKR + (tok0 + l) * 1024 + which * 512 + h * 128 + 8 * c16); }
#pragma unroll
    for (int j = 0; j < 4; ++j) { const int it = tid + NTHREADS * j, c16 = it & 15, e = it >> 4; r.kv[j] = *(const u32x4*)(L0_RS + (((size_t)ch * 4 + h) * 128 + e) * 128 + 8 * c16); }
    const int e2 = tid & 63, rg = tid >> 6;
#pragma unroll
    for (int j = 0; j < 8; ++j) r.vv[j] = *(const unsigned*)(P0 + (tok0 + 8 * rg + j) * N0 + 1024 + h * 128 + 2 * e2);
}
DI void ret_commit(LAS unsigned char* lds, int tid, const RetPf& r) {
    LAS bf16_t* QS = (LAS bf16_t*)lds; LAS bf16_t* KS = (LAS bf16_t*)(lds + 17408); LAS bf16_t* VT = (LAS bf16_t*)(lds + 34816); LAS bf16_t* KV = (LAS bf16_t*)(lds + 53248);
#pragma unroll
    for (int j = 0; j < 4; ++j) { const int it = tid + NTHREADS * j, c16 = it & 15, l = (it >> 4) & 63, which = it >> 10; *(LAS u32x4*)((which ? KS : QS) + l * 136 + 8 * c16) = r.qk[j]; }
#pragma unroll
    for (int j = 0; j < 4; ++j) { const int it = tid + NTHREADS * j, c16 = it & 15, e = it >> 4; *(LAS u32x4*)(KV + e * 136 + 8 * c16) = r.kv[j]; }
    const int e2 = tid & 63, rg = tid >> 6;
    { u32x4 o; o.x = (r.vv[0] & 0xffffu) | (r.vv[1] << 16); o.y = (r.vv[2] & 0xffffu) | (r.vv[3] << 16); o.z = (r.vv[4] & 0xffffu) | (r.vv[5] << 16); o.w = (r.vv[6] & 0xffffu) | (r.vv[7] << 16);
      *(LAS u32x4*)(VT + (2 * e2) * 72 + 8 * rg) = o; }
    { u32x4 o; o.x = (r.vv[0] >> 16) | (r.vv[1] & 0xffff0000u); o.y = (r.vv[2] >> 16) | (r.vv[3] & 0xffff0000u); o.z = (r.vv[4] >> 16) | (r.vv[5] & 0xffff0000u); o.w = (r.vv[6] >> 16) | (r.vv[7] & 0xffff0000u);
      *(LAS u32x4*)(VT + (2 * e2 + 1) * 72 + 8 * rg) = o; }
}
struct SsdPf { u32x4 x[11]; u32x4 pv[4]; float dtv[4]; };
DI int ssd_xc(int g, int c0) { return c0 < 256 ? 256 * g + c0 : c0 < 384 ? 512 + 128 * g + c0 - 256 : 768 + 128 * g + c0 - 384; }
DI void ssd_issue(Frame& F, int us, int tid, SsdPf& r) {
    const int ch = us >> 1, g = us & 1; const long tok0 = (long)ch * 64; const int t0 = (int)(tok0 % L);
    const int oc = tid & 63, rg = tid >> 6, c0 = 8 * oc, l0 = 8 * rg; const int xc = ssd_xc(g, c0);
    const bf16_t* src = WSP(bf16_t, WS_PROJ) + (tok0 + l0 - 3) * (long)N0 + 2560 + xc;
#pragma unroll
    for (int j = 0; j < 11; ++j) { r.x[j] = (u32x4){0u, 0u, 0u, 0u}; if (t0 + l0 - 3 + j >= 0) r.x[j] = *(const u32x4*)(src + (size_t)j * N0); }
    const bf16_t* ssb = L0_SS + ((size_t)ch * 8 + 4 * g) * 8192;
#pragma unroll
    for (int j = 0; j < 4; ++j) { const int q = tid + NTHREADS * j; r.pv[j] = *(const u32x4*)(ssb + (size_t)(q >> 4) * 128 + 8 * (q & 15)); }
    if (F.wave == 7) {
#pragma unroll
        for (int hh = 0; hh < 4; ++hh) r.dtv[hh] = WSP(float, WS_DT)[(size_t)(tok0 + (tid & 63)) * 8 + 4 * g + hh]; }
}

DI void l0_phase_c(Frame& F) {
    LAS unsigned char* lds = F.lds; const int w = F.wave;
    bf16_t* P0 = WSP(bf16_t, WS_PROJ); bf16_t* mix = WSP(bf16_t, WS_MIX);
    {
        RetPf pf; if ((int)blockIdx.x < NCHT * 4) ret_issue(F, blockIdx.x, F.tid, pf);
        for (int ur = blockIdx.x; ur < NCHT * 4; ur += F.G) {
            int tid = F.tid; OPAQUE_V(tid); const int lane = tid & 63, fr = lane & 15, fq = lane >> 4;
            const int ch = ur >> 2, h = ur & 3; const long tok0 = (long)ch * 64; const float lg2 = ret_gamma_log2(h);
            LAS bf16_t* QS = (LAS bf16_t*)lds;
            LAS bf16_t* KS = (LAS bf16_t*)(lds + 17408);
            LAS bf16_t* VT = (LAS bf16_t*)(lds + 34816);
            LAS bf16_t* KV = (LAS bf16_t*)(lds + 53248);
            LAS bf16_t* SC = (LAS bf16_t*)(lds + 88064);
            LAS float* PART = (LAS float*)(lds + 97280);
            ret_commit(lds, tid, pf);
            __syncthreads();
            bf16_t gt[4][4];
#pragma unroll
            for (int r = 0; r < 4; ++r)
#pragma unroll
                for (int n = 0; n < 4; ++n) gt[r][n] = P0[(size_t)(tok0 + 16 * (w & 3) + 4 * fq + r) * N0 + 1536 + h * 128 + 16 * (4 * (w >> 2) + n) + fr];
            if (ur + F.G < NCHT * 4) ret_issue(F, ur + F.G, tid, pf);
            {
                const int ti = w >> 1, jp = w & 1; f32x4 s0 = {0.f, 0.f, 0.f, 0.f}, s1 = s0;
                bf16x8 fa[4], fb0[4], fb1[4];
#pragma unroll
                for (int kx = 0; kx < 4; ++kx) { fa[kx] = ldsfrag(QS, 16 * ti + fr, 32 * kx + 8 * fq, 136); fb0[kx] = ldsfrag(KS, 32 * jp + fr, 32 * kx + 8 * fq, 136); fb1[kx] = ldsfrag(KS, 32 * jp + 16 + fr, 32 * kx + 8 * fq, 136); }
                __builtin_amdgcn_sched_barrier(0);
#pragma unroll
                for (int kx = 0; kx < 4; ++kx) { s0 = __builtin_amdgcn_mfma_f32_16x16x32_bf16(fa[kx], fb0[kx], s0, 0, 0, 0); s1 = __builtin_amdgcn_mfma_f32_16x16x32_bf16(fa[kx], fb1[kx], s1, 0, 0, 0); }
#pragma unroll
                for (int jj = 0; jj < 2; ++jj) { const int s = 32 * jp + 16 * jj + fr; const f32x4 v = jj ? s1 : s0;
#pragma unroll
                    for (int r = 0; r < 4; ++r) { const int l = 16 * ti + 4 * fq + r; SC[l * 72 + s] = f2bf(s <= l ? v[r] * __builtin_amdgcn_exp2f(lg2 * (float)(l - s)) : 0.f); } }
            }
            __syncthreads();
            {
                const int ti = w & 3, half = w >> 2; f32x4 y[4]; float ss[4] = {0.f, 0.f, 0.f, 0.f};
                bf16x8 aq[4], as[2];
#pragma unroll
                for (int kx = 0; kx < 4; ++kx) aq[kx] = ldsfrag(QS, 16 * ti + fr, 32 * kx + 8 * fq, 136);
                as[0] = ldsfrag(SC, 16 * ti + fr, 8 * fq, 72); as[1] = ldsfrag(SC, 16 * ti + fr, 32 + 8 * fq, 72);
                bf16x8 bv[4][2], bk[4][4];
#pragma unroll
                for (int n = 0; n < 4; ++n) { const int er = 16 * (4 * half + n) + fr; bv[n][0] = ldsfrag(VT, er, 8 * fq, 72); bv[n][1] = ldsfrag(VT, er, 32 + 8 * fq, 72);
#pragma unroll
                    for (int kx = 0; kx < 4; ++kx) bk[n][kx] = ldsfrag(KV, er, 32 * kx + 8 * fq, 136); }
                __builtin_amdgcn_sched_barrier(0);
#pragma unroll
                for (int n = 0; n < 4; ++n) { f32x4 a1 = {0.f, 0.f, 0.f, 0.f}, a2 = a1;
                    a1 = __builtin_amdgcn_mfma_f32_16x16x32_bf16(as[0], bv[n][0], a1, 0, 0, 0); a1 = __builtin_amdgcn_mfma_f32_16x16x32_bf16(as[1], bv[n][1], a1, 0, 0, 0);
#pragma unroll
                    for (int kx = 0; kx < 4; ++kx) a2 = __builtin_amdgcn_mfma_f32_16x16x32_bf16(aq[kx], bk[n][kx], a2, 0, 0, 0);
#pragma unroll
                    for (int r = 0; r < 4; ++r) { const float v = a1[r] + a2[r] * __builtin_amdgcn_exp2f(lg2 * (float)(16 * ti + 4 * fq + r + 1)); y[n][r] = v; ss[r] += v * v; } }
#pragma unroll
                for (int r = 0; r < 4; ++r) { float v = ss[r]; v += __shfl_xor(v, 1); v += __shfl_xor(v, 2); v += __shfl_xor(v, 4); v += __shfl_xor(v, 8); if (fr == 0) PART[(16 * ti + 4 * fq + r) * 2 + half] = v; }
                __syncthreads();
#pragma unroll
                for (int r = 0; r < 4; ++r) { const int l = 16 * ti + 4 * fq + r; const float rr = __builtin_amdgcn_rsqf((PART[l * 2] + PART[l * 2 + 1]) * (1.0f / 128.0f) + EPS); const size_t tok = (size_t)(tok0 + l);
#pragma unroll
                    for (int n = 0; n < 4; ++n) { const int e = 16 * (4 * half + n) + fr; mix[tok * 1024 + h * 128 + e] = f2bf(silu_f(bf2f(gt[r][n])) * y[n][r] * rr); } }
            }
            __syncthreads();
        }
    }
    {
        SsdPf pf; if ((int)blockIdx.x < NCHT * 2) ssd_issue(F, blockIdx.x, F.tid, pf);
        for (int us = blockIdx.x; us < NCHT * 2; us += F.G) {
            int tid = F.tid; OPAQUE_V(tid); const int lane = tid & 63, fr = lane & 15, fq = lane >> 4;
            const int ch = us >> 1, g = us & 1; const long tok0 = (long)ch * 64;
            LAS bf16_t* XT = (LAS bf16_t*)lds;
            LAS bf16_t* CM = (LAS bf16_t*)(lds + 36864);
            LAS bf16_t* SH = (LAS bf16_t*)(lds + 54272);
            LAS float* LC = (LAS float*)(lds + 91136);
            LAS float* DTL = LC + 256;
            LAS float* PART = LC + 512;
            LAS bf16_t* PV = (LAS bf16_t*)(lds + 93696);
            LAS bf16_t* BM = (LAS bf16_t*)(lds + 128512);
            const bf16_t* ssb = L0_SS + ((size_t)ch * 8 + 4 * g) * 8192;
            f32x4 cwl[4][2], cbl[2]; { const int xc = ssd_xc(g, 8 * (tid & 63)); conv_oct_weights(F.in[3] + xc, 1024, F.in[4] + xc, cwl, cbl); }
            if (w == 7) ssd_lacum_v(F, g, lane, pf.dtv, LC, DTL);
            { const int oc = tid & 63, rg = tid >> 6, c0 = 8 * oc, l0 = 8 * rg; u32x4 y[8];
                conv_oct_apply(pf.x, cwl, cbl, y);
                if (c0 < 256) {
#pragma unroll
                    for (int c = 0; c < 8; ++c) *(LAS u32x4*)(XT + (c0 + c) * 72 + ((rg ^ (oc & 7)) << 3)) = pack_col(y, c);
                } else { LAS bf16_t* dst = c0 < 384 ? BM + c0 - 256 : CM + c0 - 384;
#pragma unroll
                    for (int r = 0; r < 8; ++r) *(LAS u32x4*)(dst + (l0 + r) * 136) = y[r]; } }
            u32x4 pv[4];
#pragma unroll
            for (int j = 0; j < 4; ++j) { const int q = tid + NTHREADS * j; *(LAS u32x4*)(PV + (q >> 4) * 136 + 8 * (q & 15)) = pf.pv[j]; pv[j] = *(const u32x4*)(ssb + (size_t)(128 + (q >> 4)) * 128 + 8 * (q & 15)); }
            __syncthreads();
            bf16_t zz[2][4][4];
            { const int l0r = 16 * (w & 3) + 4 * fq, hs = w >> 2;
#pragma unroll
            for (int rd = 0; rd < 2; ++rd)
#pragma unroll
                for (int pt = 0; pt < 4; ++pt)
#pragma unroll
                    for (int r = 0; r < 4; ++r) zz[rd][pt][r] = P0[(size_t)(tok0 + l0r + r) * N0 + 2048 + 256 * g + (2 * rd + hs) * 64 + 16 * pt + fr]; }
            if (us + F.G < NCHT * 2) ssd_issue(F, us + F.G, tid, pf);
            {
                const int ti = w >> 1, jp = w & 1; f32x4 s0 = {0.f, 0.f, 0.f, 0.f}, s1 = s0;
                bf16x8 fa[4], fb0[4], fb1[4];
#pragma unroll
                for (int kx = 0; kx < 4; ++kx) { fa[kx] = ldsfrag(CM, 16 * ti + fr, 32 * kx + 8 * fq, 136); fb0[kx] = ldsfrag(BM, 32 * jp + fr, 32 * kx + 8 * fq, 136); fb1[kx] = ldsfrag(BM, 32 * jp + 16 + fr, 32 * kx + 8 * fq, 136); }
                __builtin_amdgcn_sched_barrier(0);
#pragma unroll
                for (int kx = 0; kx < 4; ++kx) { s0 = __builtin_amdgcn_mfma_f32_16x16x32_bf16(fa[kx], fb0[kx], s0, 0, 0, 0); s1 = __builtin_amdgcn_mfma_f32_16x16x32_bf16(fa[kx], fb1[kx], s1, 0, 0, 0); }
#pragma unroll
                for (int hh = 0; hh < 4; ++hh)
#pragma unroll
                    for (int jj = 0; jj < 2; ++jj) { const int s = 32 * jp + 16 * jj + fr; const f32x4 v = jj ? s1 : s0; const float las = LC[hh * 64 + s], dts = DTL[hh * 64 + s], dsk = F.in[7][4 * g + hh];
#pragma unroll
                        for (int r = 0; r < 4; ++r) { const int l = 16 * ti + 4 * fq + r;
                            SH[(hh * 64 + l) * 72 + s] = f2bf(s <= l ? v[r] * __expf(LC[hh * 64 + l] - las) * dts + (s == l ? dsk : 0.f) : 0.f); } }
            }
            __syncthreads();
            {
                const int ti = w & 3, hs = w >> 2, l0r = 16 * ti + 4 * fq; bf16x8 ac[4]; f32x4 yv[2][4]; f32x4 ss = {0.f, 0.f, 0.f, 0.f};
#pragma unroll
                for (int kx = 0; kx < 4; ++kx) ac[kx] = ldsfrag(CM, 16 * ti + fr, 32 * kx + 8 * fq, 136);
#pragma unroll
                for (int rd = 0; rd < 2; ++rd) { const int hh = 2 * rd + hs;
                    const bf16x8 sh0 = ldsfrag(SH, hh * 64 + 16 * ti + fr, 8 * fq, 72), sh1 = ldsfrag(SH, hh * 64 + 16 * ti + fr, 32 + 8 * fq, 72);
#pragma unroll
                    for (int pt = 0; pt < 4; ++pt) { const int pr = 16 * pt + fr; bf16x8 bx[2], bp[4];
                        const int swx = (2 * pt + (fr >> 3)) & 7; bx[0] = ldsfrag(XT, hh * 64 + pr, 8 * (fq ^ swx), 72); bx[1] = ldsfrag(XT, hh * 64 + pr, 8 * ((4 + fq) ^ swx), 72);
#pragma unroll
                        for (int kx = 0; kx < 4; ++kx) bp[kx] = ldsfrag(PV, hs * 64 + pr, 32 * kx + 8 * fq, 136);
                        __builtin_amdgcn_sched_barrier(0);
                        f32x4 a1 = {0.f, 0.f, 0.f, 0.f}, a2 = a1;
                        a1 = __builtin_amdgcn_mfma_f32_16x16x32_bf16(sh0, bx[0], a1, 0, 0, 0); a1 = __builtin_amdgcn_mfma_f32_16x16x32_bf16(sh1, bx[1], a1, 0, 0, 0);
#pragma unroll
                        for (int kx = 0; kx < 4; ++kx) a2 = __builtin_amdgcn_mfma_f32_16x16x32_bf16(ac[kx], bp[kx], a2, 0, 0, 0);
#pragma unroll
                        for (int r = 0; r < 4; ++r) { const int l = l0r + r; const float v = (a1[r] + a2[r] * __expf(LC[hh * 64 + l])) * silu_f(bf2f(zz[rd][pt][r])); yv[rd][pt][r] = v; ss[r] += v * v; } }
                    if (rd == 0) { __syncthreads();
#pragma unroll
                        for (int j = 0; j < 4; ++j) { const int q = tid + NTHREADS * j; *(LAS u32x4*)(PV + (q >> 4) * 136 + 8 * (q & 15)) = pv[j]; }
                        __syncthreads(); } }
#pragma unroll
                for (int r = 0; r < 4; ++r) { float v = ss[r]; v += __shfl_xor(v, 1); v += __shfl_xor(v, 2); v += __shfl_xor(v, 4); v += __shfl_xor(v, 8); if (fr == 0) PART[(l0r + r) * 2 + hs] = v; }
                __syncthreads();
                bf16_t* mrow = mix + (size_t)(tok0 + l0r) * 1024 + 512 + 256 * g + fr;
#pragma unroll
                for (int r = 0; r < 4; ++r) { const float rr = __builtin_amdgcn_rsqf((PART[(l0r + r) * 2] + PART[(l0r + r) * 2 + 1]) * (1.0f / 256.0f) + EPS);
#pragma unroll
                    for (int rd = 0; rd < 2; ++rd)
#pragma unroll
                        for (int pt = 0; pt < 4; ++pt) { const int c = (2 * rd + hs) * 64 + 16 * pt; mrow[(size_t)r * 1024 + c] = f2bf(yv[rd][pt][r] * rr * F.in[8][256 * g + c + fr]); } }
            }
            __syncthreads();
        }
    }
}

#define P1B WSP(bf16_t, WS_PROJ)
#define QC WSP(bf16_t, WS_PROJ + (size_t)T * N1 * 2)
#define KC WSP(bf16_t, WS_TAIL)
#define VC WSP(bf16_t, WS_XN)
#define YG WSP(bf16_t, WS_YG)
DI void l1_conv(Frame& F, int c_lo, int c_hi) {
    const int nc = c_hi - c_lo;
    for (long idx = F.gtid; idx < (long)T * nc; idx += F.gthreads) {
        const int c = c_lo + (int)(idx % nc); const long tok = idx / nc; const int t = (int)(tok % L);
        float a = 0.f;
#pragma unroll
        for (int j = 0; j < 4; ++j) if (t - 3 + j >= 0) a += F.in[15][j * 2304 + c] * bf2f(P1B[(size_t)(tok - 3 + j) * N1 + c]);
        const bf16_t o = f2bf(silu_f(a));
        if (c < 768) QC[(size_t)tok * 768 + c] = o; else if (c < 1536) KC[(size_t)tok * 768 + c - 768] = o; else VC[(size_t)tok * 768 + c - 1536] = o;
    }
}
DI void l1_gdn_ba(Frame& F) {
    for (long idx = F.gtid; idx < (long)T * 12; idx += F.gthreads) {
        const int j = (int)(idx % 12); const size_t tok = (size_t)(idx / 12); const bf16_t* xr = WSP(bf16_t, WS_XN) + tok * D; float a = 0.f;
        for (int k = 0; k < D; ++k) a += bf2f(xr[k]) * F.in[13][k] * F.in[14][(size_t)k * N1SRC + 3072 + j];
        a *= pg8::row_rs(WSP(float, WS_SSQ), (int)tok);
        WSP(float, WS_BG)[tok * 16 + j] = j < 6 ? sigmoid_f(a) : -expf(F.in[16][j - 6]) * softplus_f(a + F.in[17][j - 6]);
    }
}
DI void l1_s5_scan(Frame& F) {
    for (int wi = F.gwave; wi < 32; wi += F.gwaves) {
        const int g = wi & 15, b = wi >> 4, n = F.lane;
        const f32x2 lam = WSP(f32x2, WS_S5C)[g * 64 + n];
        f32x2 bb[16], cc[16]; float dsk[16];
#pragma unroll
        for (int c = 0; c < 16; ++c) { bb[c] = WSP(f32x2, WS_S5C + 16 * 64 * 8)[(g * 64 + n) * 16 + c]; cc[c] = (f32x2){F.in[24][(g * 16 + c) * 64 + n], F.in[25][(g * 16 + c) * 64 + n]}; dsk[c] = F.in[26][g * 16 + c]; }
        float hre = 0.f, him = 0.f;
#pragma unroll 1
        for (int t = 0; t < L; ++t) { const size_t tok = (size_t)b * L + t; const bf16_t* up = P1B + tok * N1 + 3072 + g * 16;
            float u[16]; float bre = 0.f, bim = 0.f;
#pragma unroll
            for (int c = 0; c < 16; ++c) { u[c] = bf2f(up[c]); bre += u[c] * bb[c][0]; bim += u[c] * bb[c][1]; }
            const float nre = lam[0] * hre - lam[1] * him + bre, nim = lam[0] * him + lam[1] * hre + bim; hre = nre; him = nim;
            float mine = 0.f;
#pragma unroll
            for (int c = 0; c < 16; ++c) { const float y = wave_sum(cc[c][0] * hre - cc[c][1] * him) + dsk[c] * u[c]; mine = (n == c) ? y : mine; }
            if (n < 16) YG[tok * 256 + g * 16 + n] = f2bf(gelu_tanh_f(mine));
        }
    }
}
DI void l1_level_b(Frame& F) {
    for (long idx = F.gtid; idx < (long)T * 12; idx += F.gthreads) {
        const int h = (int)(idx % 6), which = (int)((idx / 6) & 1); const size_t tok = (size_t)(idx / 12); bf16_t* p = (which ? KC : QC) + tok * 768 + h * 128; float ss = 0.f;
        for (int d = 0; d < 128; ++d) { const float x = bf2f(p[d]); ss += x * x; }
        const float r = (1.0f / sqrtf(ss + EPS)) * (which ? 1.0f : 0.08838834764831845f);
        for (int d = 0; d < 128; ++d) p[d] = f2bf(bf2f(p[d]) * r);
    }
    for (long idx = F.gtid; idx < (long)NCHT * 6; idx += F.gthreads) {
        const int h = (int)(idx % 6); const long ch = idx / 6; float run = 0.f;
        for (int l = 0; l < 64; ++l) { const size_t tok = (size_t)ch * 64 + l; run += WSP(float, WS_BG)[tok * 16 + 6 + h]; WSP(float, WS_GC)[tok * 8 + h] = run; }
    }
}
DI void l1_s5_glu(Frame& F) {
    for (long idx = F.gtid; idx < (long)T * 256; idx += F.gthreads) {
        const int c = (int)(idx & 255); const size_t tok = (size_t)(idx >> 8); const bf16_t* y = YG + tok * 256; float z = F.in[28][c];
        for (int j = 0; j < 256; ++j) z += bf2f(y[j]) * F.in[27][j * 256 + c];
        WSP(bf16_t, WS_MIX)[tok * 1024 + 768 + c] = f2bf(bf2f(y[c]) * sigmoid_f(z));
    }
}
DI void l1_level_c(Frame& F) {
    for (long idx = F.gtid; idx < (long)NCHT * 6 * 4096; idx += F.gthreads) {
        const int s = (int)(idx & 63), l = (int)((idx >> 6) & 63); const long r2 = idx >> 12; const int h = (int)(r2 % 6); const long ch = r2 / 6;
        const size_t tl = (size_t)ch * 64 + l, ts = (size_t)ch * 64 + s; float att = 0.f, low = 0.f;
        if (s <= l) { const bf16_t* q = QC + tl * 768 + h * 128; const bf16_t* kl = KC + tl * 768 + h * 128; const bf16_t* ks = KC + ts * 768 + h * 128; float qk = 0.f, kk = 0.f;
            for (int d = 0; d < 128; ++d) { const float kv = bf2f(ks[d]); qk += bf2f(q[d]) * kv; kk += bf2f(kl[d]) * kv; }
            const float dec = expf(WSP(float, WS_GC)[tl * 8 + h] - WSP(float, WS_GC)[ts * 8 + h]);
            att = qk * dec; if (s < l) low = WSP(float, WS_BG)[tl * 16 + h] * kk * dec; }
        P1B[tl * N1 + 1536 + h * 128 + s] = f2bf(att); P1B[tl * N1 + 1536 + h * 128 + 64 + s] = f2bf(low);
    }
}
DI void l1_level_d(Frame& F) {
    LAS float* x = (LAS float*)F.lds + F.tid;
    for (long idx = F.gtid; idx < (long)NCHT * 6 * 256; idx += F.gthreads) {
        const int col = (int)(idx & 255); const long r2 = idx >> 8; const int h = (int)(r2 % 6); const long ch = r2 / 6;
#pragma unroll 1
        for (int l = 0; l < 64; ++l) { const size_t tok = (size_t)ch * 64 + l; const float beta = WSP(float, WS_BG)[tok * 16 + h];
            float r = col < 128 ? bf2f(VC[tok * 768 + h * 128 + col]) * beta : bf2f(KC[tok * 768 + h * 128 + col - 128]) * beta * expf(WSP(float, WS_GC)[tok * 8 + h]);
            const bf16_t* low = P1B + tok * N1 + 1536 + h * 128 + 64;
            for (int s = 0; s < l; ++s) r -= bf2f(low[s]) * x[s * 512];
            x[l * 512] = r; }
#pragma unroll 1
        for (int l = 0; l < 64; ++l) { const size_t tok = (size_t)ch * 64 + l; P1B[tok * N1 + (col < 128 ? h * 128 + col : 768 + h * 128 + col - 128)] = f2bf(x[l * 512]); }
    }
}
DI void l1_level_e(Frame& F) {
    if (F.gtid < 1536) {
        const int e = (int)(F.gtid & 127); const int bh = (int)(F.gtid >> 7), h = bh % 6, b = bh / 6;
        LAS float* vn = (LAS float*)F.lds + F.tid;
        float S[128];
#pragma unroll
        for (int d = 0; d < 128; ++d) S[d] = 0.f;
#pragma unroll 1
        for (int c = 0; c < L / 64; ++c) {
            const size_t tok0 = (size_t)b * L + c * 64; const float gl = WSP(float, WS_GC)[(tok0 + 63) * 8 + h];
#pragma unroll 1
            for (int l = 0; l < 64; ++l) { const size_t tok = tok0 + l; const u32x4* w = (const u32x4*)(P1B + tok * N1 + 768 + h * 128); float a = bf2f(P1B[tok * N1 + h * 128 + e]);
#pragma unroll
                for (int d8 = 0; d8 < 16; ++d8) { const u32x4 ww = w[d8];
#pragma unroll
                    for (int j = 0; j < 4; ++j) { a -= __uint_as_float(ww[j] << 16) * S[d8 * 8 + 2 * j]; a -= __uint_as_float(ww[j] & 0xffff0000u) * S[d8 * 8 + 2 * j + 1]; } }
                vn[l * 512] = a; }
#pragma unroll 1
            for (int l = 0; l < 64; ++l) { const size_t tok = tok0 + l; const u32x4* q = (const u32x4*)(QC + tok * 768 + h * 128); float a = 0.f;
#pragma unroll
                for (int d8 = 0; d8 < 16; ++d8) { const u32x4 ww = q[d8];
#pragma unroll
                    for (int j = 0; j < 4; ++j) { a += __uint_as_float(ww[j] << 16) * S[d8 * 8 + 2 * j]; a += __uint_as_float(ww[j] & 0xffff0000u) * S[d8 * 8 + 2 * j + 1]; } }
                a *= expf(WSP(float, WS_GC)[tok * 8 + h]);
                const bf16_t* att = P1B + tok * N1 + 1536 + h * 128;
                for (int s = 0; s <= l; ++s) a += bf2f(att[s]) * vn[s * 512];
                P1B[tok * N1 + h * 128 + e] = f2bf(a); }
            const float cd = expf(gl);
#pragma unroll
            for (int d = 0; d < 128; ++d) S[d] *= cd;
#pragma unroll 1
            for (int l = 0; l < 64; ++l) { const size_t tok = tok0 + l; const u32x4* k = (const u32x4*)(KC + tok * 768 + h * 128); const float vv = vn[l * 512] * expf(gl - WSP(float, WS_GC)[tok * 8 + h]);
#pragma unroll
                for (int d8 = 0; d8 < 16; ++d8) { const u32x4 ww = k[d8];
#pragma unroll
                    for (int j = 0; j < 4; ++j) { S[d8 * 8 + 2 * j] += __uint_as_float(ww[j] << 16) * vv; S[d8 * 8 + 2 * j + 1] += __uint_as_float(ww[j] & 0xffff0000u) * vv; } } }
        }
    }
}
DI void l1_level_f(Frame& F) {
    for (long idx = F.gtid; idx < (long)T * 6; idx += F.gthreads) {
        const int h = (int)(idx % 6); const size_t tok = (size_t)(idx / 6); const bf16_t* o = P1B + tok * N1 + h * 128; float ss = 0.f;
        for (int e = 0; e < 128; ++e) { const float v = bf2f(o[e]); ss += v * v; }
        const float r = 1.0f / sqrtf(ss * (1.0f / 128.0f) + EPS);
        for (int e = 0; e < 128; ++e) WSP(bf16_t, WS_MIX)[tok * 1024 + h * 128 + e] = f2bf(bf2f(o[e]) * r * F.in[18][e] * silu_f(bf2f(P1B[tok * N1 + 2304 + h * 128 + e])));
    }
}

constexpr int GDN_UNITS = NCHT * 6;
constexpr size_t WS_G_FLAG = WS_CTL + 16384;
#ifndef CPU_EMU
DI void flag_publish(unsigned* p) { __hip_atomic_store(p, 1u, __ATOMIC_RELAXED, __HIP_MEMORY_SCOPE_AGENT); }
DI void flag_wait(unsigned* p) { unsigned sp = 0; while (__hip_atomic_load(p, __ATOMIC_RELAXED, __HIP_MEMORY_SCOPE_AGENT) == 0u) { __builtin_amdgcn_s_sleep(8); if (++sp > (1u << 24)) break; } }
DI void acquire_agent() { __builtin_amdgcn_fence(__ATOMIC_ACQUIRE, "agent"); asm volatile("s_waitcnt vmcnt(0)" ::: "memory"); }
#else
DI void flag_publish(unsigned* p) { *(volatile unsigned*)p = 1u; }
DI void flag_wait(unsigned* p) { while (*(volatile unsigned*)p == 0u) emu::yield(); }
DI void acquire_agent() {}
#endif
constexpr size_t WS_G_WF = WS_XN;
constexpr size_t WS_G_QGF = WS_G_WF + (size_t)GDN_UNITS * 16384;
constexpr size_t WS_G_ATF = WS_G_QGF + (size_t)GDN_UNITS * 16384;
constexpr size_t WS_G_KTF = WS_PROJ + (size_t)T * N1 * 2;
constexpr size_t WS_G_UP = WS_G_KTF + (size_t)GDN_UNITS * 16384;
constexpr size_t WS_G_CD = WS_LAC;
static_assert(WS_G_ATF + (size_t)GDN_UNITS * 8192 <= WS_PROJ && WS_G_UP + (size_t)GDN_UNITS * 16384 <= WS_END && (size_t)GDN_UNITS * 4 <= (size_t)T * 32 && (size_t)T * 512 <= WS_W_IN1 - WS_W_IN0, "gdn workspace");

DI void gdn_g1(Frame& F, int first, int stride) {
    LAS unsigned char* lds = F.lds;
    LAS bf16_t* QS = (LAS bf16_t*)(lds);
    LAS bf16_t* KS = (LAS bf16_t*)(lds + 17408);
    LAS bf16_t* KTt = (LAS bf16_t*)(lds + 34816);
    LAS bf16_t* VTt = (LAS bf16_t*)(lds + 53248);
    LAS float* LM = (LAS float*)(lds + 71680);
    LAS bf16_t* USm = (LAS bf16_t*)(lds + 71680);
    LAS bf16_t* TU = (LAS bf16_t*)(lds + 89088);
    LAS bf16_t* TW = (LAS bf16_t*)(lds + 98304);
    LAS bf16_t* AT = (LAS bf16_t*)(lds + 107520);
    LAS bf16_t* WSm = (LAS bf16_t*)(lds + 116736);
    LAS float* TM = (LAS float*)(lds + 116736);
    LAS float* SM = (LAS float*)(lds + 134144);
    LAS float* PS = (LAS float*)(lds + 135168);
    const int w = F.wave;
    const bf16_t* P1 = WSP(bf16_t, WS_PROJ);
    for (int ui = first; ui < GDN_UNITS; ui += stride) {
        const int u = (((ui % 12) / 6) * (L / 64) + ui / 12) * 6 + (ui % 12) % 6;
        int tid = F.tid; OPAQUE_V(tid);
        const int lane = tid & 63, fr = lane & 15, fq = lane >> 4;
        const int ch = u / 6, h = u % 6; const long tok0 = (long)ch * 64; const int t0 = (int)(tok0 % L);
        if (tid < 384) {
            const int oc = tid % 48, rg = tid / 48, c0 = 8 * oc, which = c0 >> 7, d = c0 & 127, gcol = which * 768 + h * 128 + d, l0 = 8 * rg; u32x4 y[8];
            conv_oct(P1 + (size_t)(tok0 + l0 - 3) * N1 + gcol, N1, t0 + l0 - 3, F.in[15] + gcol, 2304, nullptr, y);
            if (which == 0) {
#pragma unroll
                for (int r = 0; r < 8; ++r) *(LAS u32x4*)(QS + (l0 + r) * 136 + d) = y[r];
            } else if (which == 1) {
#pragma unroll
                for (int r = 0; r < 8; ++r) *(LAS u32x4*)(KS + (l0 + r) * 136 + d) = y[r];
#pragma unroll
                for (int c = 0; c < 8; ++c) *(LAS u32x4*)(KTt + (d + c) * 72 + ((rg ^ (oc & 7)) << 3)) = pack_col(y, c);
            } else {
#pragma unroll
                for (int c = 0; c < 8; ++c) *(LAS u32x4*)(VTt + (d + c) * 72 + ((rg ^ (oc & 7)) << 3)) = pack_col(y, c);
            }
        } else if (tid < 448) {
            const int l = tid - 384; const float* bg = WSP(float, WS_BG) + (size_t)(tok0 + l) * 16; float g = -expf(F.in[16][h]) * softplus_f(bg[6 + h] + F.in[17][h]);
#pragma unroll
            for (int o = 1; o < 64; o <<= 1) { const float t = __shfl_up(g, o); if (l >= o) g += t; }
            SM[l] = g; SM[64 + l] = sigmoid_f(bg[h]);
        }
        __syncthreads();
        const int ti = w >> 1, jp = w & 1;
        f32x4 kk0 = {0.f, 0.f, 0.f, 0.f}, kk1 = kk0, qk0 = kk0, qk1 = kk0, qq = kk0;
#pragma unroll
        for (int kx = 0; kx < 4; ++kx) {
            const bf16x8 ak = ldsfrag(KS, 16 * ti + fr, 32 * kx + 8 * fq, 136), aq = ldsfrag(QS, 16 * ti + fr, 32 * kx + 8 * fq, 136);
            const bf16x8 b0 = ldsfrag(KS, 32 * jp + fr, 32 * kx + 8 * fq, 136), b1 = ldsfrag(KS, 32 * jp + 16 + fr, 32 * kx + 8 * fq, 136);
            kk0 = __builtin_amdgcn_mfma_f32_16x16x32_bf16(ak, b0, kk0, 0, 0, 0); kk1 = __builtin_amdgcn_mfma_f32_16x16x32_bf16(ak, b1, kk1, 0, 0, 0);
            qk0 = __builtin_amdgcn_mfma_f32_16x16x32_bf16(aq, b0, qk0, 0, 0, 0); qk1 = __builtin_amdgcn_mfma_f32_16x16x32_bf16(aq, b1, qk1, 0, 0, 0);
            if (jp == 0) qq = __builtin_amdgcn_mfma_f32_16x16x32_bf16(aq, aq, qq, 0, 0, 0);
        }
        if ((fr >> 2) == fq) {
            if (jp == (ti >> 1)) SM[128 + 16 * ti + fr] = sel4((ti & 1) ? kk1 : kk0, fr & 3);
            if (jp == 0) SM[192 + 16 * ti + fr] = sel4(qq, fr & 3);
        }
        __syncthreads();
#pragma unroll
        for (int jj = 0; jj < 2; ++jj) { const int s = 32 * jp + 16 * jj + fr; const float rks = __builtin_amdgcn_rsqf(SM[128 + s] + EPS), gs = SM[s]; const f32x4 kv = jj ? kk1 : kk0, qv = jj ? qk1 : qk0;
#pragma unroll
            for (int r = 0; r < 4; ++r) { const int l = 16 * ti + 4 * fq + r; const float dec = s <= l ? __expf(SM[l] - gs) : 0.f;
                const float rkl = __builtin_amdgcn_rsqf(SM[128 + l] + EPS), rql = 0.08838834764831845f * __builtin_amdgcn_rsqf(SM[192 + l] + EPS);
                LM[l * 68 + s] = s < l ? SM[64 + l] * kv[r] * rkl * rks * dec : 0.f;
                AT[l * 72 + s] = f2bf(qv[r] * rql * rks * dec); } }
        __syncthreads();
        if (w == 0) {
            const int blk = lane >> 4, j = lane & 15; const LAS float* Lb = LM + (16 * blk) * 68 + 16 * blk; float x[16];
#pragma unroll
            for (int r = 0; r < 16; ++r) { float a = (r == j) ? 1.f : 0.f;
#pragma unroll
                for (int s2 = 0; s2 < r; ++s2) a -= Lb[r * 68 + s2] * x[s2];
                x[r] = a; }
#pragma unroll
            for (int r = 0; r < 16; ++r) TM[(16 * blk + r) * 68 + 16 * blk + j] = x[r];
        }
        __syncthreads();
#pragma unroll
        for (int lev = 1; lev <= 3; ++lev) {
            if (w < 4 - lev) { const int bi = w + lev, bj = w; f32x4 acc = {0.f, 0.f, 0.f, 0.f};
                for (int k = bj; k < bi; ++k)
#pragma unroll
                    for (int kx = 0; kx < 4; ++kx) acc = __builtin_amdgcn_mfma_f32_16x16x4f32(LM[(16 * bi + fr) * 68 + 16 * k + 4 * kx + fq], TM[(16 * k + 4 * kx + fq) * 68 + 16 * bj + fr], acc, 0, 0, 0);
                LAS float* sc = PS + w * 320;
#pragma unroll
                for (int r = 0; r < 4; ++r) sc[(4 * fq + r) * 20 + fr] = acc[r];
                WAIT_L(0);
                f32x4 t2 = {0.f, 0.f, 0.f, 0.f};
#pragma unroll
                for (int kx = 0; kx < 4; ++kx) t2 = __builtin_amdgcn_mfma_f32_16x16x4f32(TM[(16 * bi + fr) * 68 + 16 * bi + 4 * kx + fq], sc[(4 * kx + fq) * 20 + fr], t2, 0, 0, 0);
#pragma unroll
                for (int r = 0; r < 4; ++r) TM[(16 * bi + 4 * fq + r) * 68 + 16 * bj + fr] = -t2[r];
            }
            __syncthreads();
        }
        {
            for (int idx = tid; idx < 4096; idx += NTHREADS) { const int l = idx >> 6, s2 = idx & 63; const float t = (s2 >> 4) <= (l >> 4) ? TM[l * 68 + s2] : 0.f; const float bj = SM[64 + s2];
                TU[l * 72 + s2] = f2bf(t * bj); TW[l * 72 + s2] = f2bf(t * bj * __expf(SM[s2]) * __builtin_amdgcn_rsqf(SM[128 + s2] + EPS)); }
            if (tid == 0) store4_wt(WSP(float, WS_G_CD) + u, expf(SM[63]));
            const float glast = SM[63];
            for (int it = tid; it < 2560; it += NTHREADS) {
                if (it < 1024) { const int f = it >> 6, ln = it & 63, l = 16 * (f >> 2) + (ln & 15), d0 = 32 * (f & 3) + 4 * (ln >> 4);
                    const float sc = 0.08838834764831845f * __builtin_amdgcn_rsqf(SM[192 + l] + EPS) * __expf(SM[l]);
                    const u32x2 a = *(const LAS u32x2*)(QS + l * 136 + d0), b = *(const LAS u32x2*)(QS + l * 136 + d0 + 16);
                    u32x4 o; o.x = pk2(__uint_as_float(a.x << 16) * sc, __uint_as_float(a.x & 0xffff0000u) * sc); o.y = pk2(__uint_as_float(a.y << 16) * sc, __uint_as_float(a.y & 0xffff0000u) * sc);
                    o.z = pk2(__uint_as_float(b.x << 16) * sc, __uint_as_float(b.x & 0xffff0000u) * sc); o.w = pk2(__uint_as_float(b.y << 16) * sc, __uint_as_float(b.y & 0xffff0000u) * sc);
                    store16_wt(F.ws + WS_G_QGF + (size_t)u * 16384 + it * 16, o);
                } else if (it < 2048) { const int i2 = it - 1024, f = i2 >> 6, ln = i2 & 63, d = 16 * (f >> 1) + (ln & 15), k0 = 32 * (f & 1) + 4 * (ln >> 4);
                    float sc[8];
#pragma unroll
                    for (int j = 0; j < 8; ++j) { const int tk = k0 + 16 * (j >> 2) + (j & 3); sc[j] = __expf(glast - SM[tk]) * __builtin_amdgcn_rsqf(SM[128 + tk] + EPS); }
                    const int swk = (d >> 3) & 7; const u32x2 a = *(const LAS u32x2*)(KTt + d * 72 + ((((k0 >> 3) ^ swk) << 3) | (k0 & 7))), b = *(const LAS u32x2*)(KTt + d * 72 + (((((k0 + 16) >> 3) ^ swk) << 3) | (k0 & 7)));
                    u32x4 o; o.x = pk2(__uint_as_float(a.x << 16) * sc[0], __uint_as_float(a.x & 0xffff0000u) * sc[1]); o.y = pk2(__uint_as_float(a.y << 16) * sc[2], __uint_as_float(a.y & 0xffff0000u) * sc[3]);
                    o.z = pk2(__uint_as_float(b.x << 16) * sc[4], __uint_as_float(b.x & 0xffff0000u) * sc[5]); o.w = pk2(__uint_as_float(b.y << 16) * sc[6], __uint_as_float(b.y & 0xffff0000u) * sc[7]);
                    store16_wt(F.ws + WS_G_KTF + (size_t)u * 16384 + i2 * 16, o);
                } else { const int i2 = it - 2048, f = i2 >> 6, ln = i2 & 63, l = 16 * (f >> 1) + (ln & 15), k0 = 32 * (f & 1) + 4 * (ln >> 4);
                    const u32x2 a = *(const LAS u32x2*)(AT + l * 72 + k0), b = *(const LAS u32x2*)(AT + l * 72 + k0 + 16);
                    u32x4 o; o.x = a.x; o.y = a.y; o.z = b.x; o.w = b.y;
                    store16_wt(F.ws + WS_G_ATF + (size_t)u * 8192 + i2 * 16, o); }
            }
        }
        __syncthreads();
        {
            f32x4 au[4], aw[4];
#pragma unroll
            for (int n = 0; n < 4; ++n) { au[n] = (f32x4){0.f, 0.f, 0.f, 0.f}; aw[n] = au[n]; }
#pragma unroll
            for (int k2 = 0; k2 < 2; ++k2) { const bf16x8 fu = ldsfrag(TU, 16 * ti + fr, 32 * k2 + 8 * fq, 72), fw = ldsfrag(TW, 16 * ti + fr, 32 * k2 + 8 * fq, 72);
#pragma unroll
                for (int n = 0; n < 4; ++n) { const int col = 16 * (4 * jp + n) + fr, cs = 8 * ((4 * k2 + fq) ^ ((2 * n + (fr >> 3)) & 7));
                    au[n] = __builtin_amdgcn_mfma_f32_16x16x32_bf16(fu, ldsfrag(VTt, col, cs, 72), au[n], 0, 0, 0);
                    aw[n] = __builtin_amdgcn_mfma_f32_16x16x32_bf16(fw, ldsfrag(KTt, col, cs, 72), aw[n], 0, 0, 0); } }
#pragma unroll
            for (int n = 0; n < 4; ++n)
#pragma unroll
                for (int r = 0; r < 4; ++r) { const int l = 16 * ti + 4 * fq + r, col = 16 * (4 * jp + n) + fr; USm[l * 136 + col] = f2bf(au[n][r]); WSm[l * 136 + col] = f2bf(aw[n][r]); }
        }
        __syncthreads();
        for (int it = tid; it < 1536; it += NTHREADS) {
            if (it < 1024) { const int f = it >> 6, ln = it & 63, l = 16 * (f >> 2) + (ln & 15), d0 = 32 * (f & 3) + 4 * (ln >> 4);
                const u32x2 a = *(const LAS u32x2*)(WSm + l * 136 + d0), b = *(const LAS u32x2*)(WSm + l * 136 + d0 + 16);
                u32x4 o; o.x = a.x; o.y = a.y; o.z = b.x; o.w = b.y; store16_wt(F.ws + WS_G_WF + (size_t)u * 16384 + it * 16, o);
            } else { const int i2 = it - 1024, sl = i2 >> 6, ln = i2 & 63, e = 16 * sl + (ln & 15); unsigned o[8];
#pragma unroll
                for (int q2 = 0; q2 < 8; ++q2) { const int i0 = 2 * q2, l = 16 * (i0 >> 2) + 4 * (ln >> 4) + (i0 & 3); o[q2] = (unsigned)USm[l * 136 + e] | ((unsigned)USm[(l + 1) * 136 + e] << 16); }
                unsigned char* dst = F.ws + WS_G_UP + (size_t)u * 16384 + i2 * 32; store16_wt(dst, (u32x4){o[0], o[1], o[2], o[3]}); store16_wt(dst + 16, (u32x4){o[4], o[5], o[6], o[7]}); }
        }
        WAIT_V(0); __syncthreads();
        if (F.tid == 0) flag_publish(WSP(unsigned, WS_G_FLAG) + u);
    }
}

#ifndef G2_PROBE_MODE
#define G2_PROBE_MODE 0
#endif
DI void gdn_g2(Frame& F, const int mode = 0) {
    constexpr int NC = L / 64; const int lane = F.lane; LAS unsigned char* lds = F.lds;
    for (int bid = blockIdx.x; bid < 64; bid += F.G) {
    const int bh = 8 * (bid >> 5) + (bid & 7), quarter = (bid >> 3) & 3, b = bh / 6, h = bh % 6; if (bh >= 12) continue;
    if (F.wave >= 2) {
        const int lw = F.wave - 2; const size_t ub = ((size_t)b * NC) * 6 + h;
        int ready = 0;
        auto ld = [&](int c, u32x4 (&v)[10], float& cdv) { if (c < NC) {
            if (c >= ready) { const int hi = c + 16 < NC ? c + 16 : NC; for (int k = ready; k < hi; ++k) flag_wait(WSP(unsigned, WS_G_FLAG) + ub + (size_t)6 * k); acquire_agent(); ready = hi; }
            const size_t u = ub + (size_t)6 * ((mode == 1 || mode == 4) ? 0 : c);
            const unsigned char* s0 = F.ws + WS_G_WF + u * 16384; const unsigned char* s1 = F.ws + WS_G_QGF + u * 16384; const unsigned char* s2 = F.ws + WS_G_KTF + u * 16384; const unsigned char* s3 = F.ws + WS_G_ATF + u * 8192;
            const unsigned char* s4 = F.ws + WS_G_UP + u * 16384 + (size_t)quarter * 4096;
#pragma unroll
            for (int k = 0; k < 10; ++k) { const int f = lw + 6 * k; const unsigned char* src = f < 16 ? s0 + f * 1024 : f < 32 ? s1 + (f - 16) * 1024 : f < 48 ? s2 + (f - 32) * 1024 : f < 56 ? s3 + (f - 48) * 1024 : s4 + (f - 56) * 1024;
                v[k] = *(const u32x4*)(src + lane * 16); }
            cdv = WSP(float, WS_G_CD)[u]; } };
        auto st = [&](int c, const u32x4 (&v)[10], float cdv) { if (c < NC) { LAS unsigned char* buf = lds + (c & 1) * 65536;
#pragma unroll
            for (int k = 0; k < 10; ++k) { const int f = lw + 6 * k; *(LAS u32x4*)(buf + f * 1024 + lane * 16) = v[k]; }
            if (lw == 0 && lane == 0) ((LAS float*)(lds + 131072))[c & 1] = cdv; } };
        u32x4 va[10], vb[10], vc[10]; float ca = 0.f, cb = 0.f, cc = 0.f;
        ld(0, va, ca); st(0, va, ca); ld(1, va, ca); ld(2, vb, cb); ld(3, vc, cc);
        WAIT_L(0); __builtin_amdgcn_s_barrier();
#pragma unroll 1
        for (int c = 0; c < NC; c += 3) {
            st(c + 1, va, ca); ld(c + 4, va, ca); WAIT_L(0); __builtin_amdgcn_s_barrier();
            if (c + 1 < NC) { st(c + 2, vb, cb); ld(c + 5, vb, cb); WAIT_L(0); __builtin_amdgcn_s_barrier(); }
            if (c + 2 < NC) { st(c + 3, vc, cc); ld(c + 6, vc, cc); WAIT_L(0); __builtin_amdgcn_s_barrier(); }
        }
    } else {
        const int sl = quarter * 2 + F.wave;
        __builtin_amdgcn_s_setprio(3);
        f32x4 S[8]; bf16x8 Sb[4];
#pragma unroll
        for (int i = 0; i < 8; ++i) S[i] = (f32x4){0.f, 0.f, 0.f, 0.f};
#pragma unroll
        for (int i = 0; i < 4; ++i) Sb[i] = pack8(S[0], S[0]);
        __builtin_amdgcn_s_barrier();
#pragma unroll 1
        for (int c = 0; c < NC; ++c) {
            if (mode == 2 || mode == 4) { __builtin_amdgcn_s_barrier(); continue; }
            const LAS unsigned char* bufb = lds + (c & 1) * 65536; const LAS unsigned char* buf = bufb + lane * 16;
            const LAS u32x4* ul = (const LAS u32x4*)(bufb + 57344 + F.wave * 2048 + lane * 32); const u32x4 u0 = ul[0], u1 = ul[1]; const float cd = ((const LAS float*)(lds + 131072))[c & 1];
#define G2_LD8(dst, off0, stride, off1) do { _Pragma("unroll") for (int _j = 0; _j < 4; ++_j) { dst[_j] = *(const LAS bf16x8*)(buf + (off0) + _j * (stride)); dst[4 + _j] = *(const LAS bf16x8*)(buf + (off1) + _j * (stride)); } } while (0)
#define G2_SCHED __builtin_amdgcn_sched_barrier(0)
            f32x4 ws[4], qs[4]; bf16x8 fa[8], fb[8];
#pragma unroll
            for (int i = 0; i < 4; ++i) { ws[i] = (f32x4){0.f, 0.f, 0.f, 0.f}; qs[i] = ws[i]; }
            G2_LD8(fa, 0, 4096, 16384);
            G2_LD8(fb, 1024, 4096, 16384 + 1024); WAIT_L(8); G2_SCHED;
#pragma unroll
            for (int i = 0; i < 4; ++i) { ws[i] = __builtin_amdgcn_mfma_f32_16x16x32_bf16(fa[i], Sb[0], ws[i], 0, 0, 0); qs[i] = __builtin_amdgcn_mfma_f32_16x16x32_bf16(fa[4 + i], Sb[0], qs[i], 0, 0, 0); }
            G2_SCHED; G2_LD8(fa, 2048, 4096, 16384 + 2048); WAIT_L(8); G2_SCHED;
#pragma unroll
            for (int i = 0; i < 4; ++i) { ws[i] = __builtin_amdgcn_mfma_f32_16x16x32_bf16(fb[i], Sb[1], ws[i], 0, 0, 0); qs[i] = __builtin_amdgcn_mfma_f32_16x16x32_bf16(fb[4 + i], Sb[1], qs[i], 0, 0, 0); }
            G2_SCHED; G2_LD8(fb, 3072, 4096, 16384 + 3072); WAIT_L(8); G2_SCHED;
#pragma unroll
            for (int i = 0; i < 4; ++i) { ws[i] = __builtin_amdgcn_mfma_f32_16x16x32_bf16(fa[i], Sb[2], ws[i], 0, 0, 0); qs[i] = __builtin_amdgcn_mfma_f32_16x16x32_bf16(fa[4 + i], Sb[2], qs[i], 0, 0, 0); }
            G2_SCHED; G2_LD8(fa, 49152, 2048, 49152 + 1024); WAIT_L(8); G2_SCHED;
#pragma unroll
            for (int i = 0; i < 4; ++i) { ws[i] = __builtin_amdgcn_mfma_f32_16x16x32_bf16(fb[i], Sb[3], ws[i], 0, 0, 0); qs[i] = __builtin_amdgcn_mfma_f32_16x16x32_bf16(fb[4 + i], Sb[3], qs[i], 0, 0, 0); }
            G2_SCHED;
            const unsigned uw[8] = {u0.x, u0.y, u0.z, u0.w, u1.x, u1.y, u1.z, u1.w};
            f32x4 vn[4];
#pragma unroll
            for (int i = 0; i < 4; ++i) { vn[i][0] = __uint_as_float(uw[2 * i] << 16) - ws[i][0]; vn[i][1] = __uint_as_float(uw[2 * i] & 0xffff0000u) - ws[i][1];
                vn[i][2] = __uint_as_float(uw[2 * i + 1] << 16) - ws[i][2]; vn[i][3] = __uint_as_float(uw[2 * i + 1] & 0xffff0000u) - ws[i][3]; }
            const bf16x8 vb0 = pack8(vn[0], vn[1]), vb1 = pack8(vn[2], vn[3]);
            G2_SCHED; G2_LD8(fb, 32768, 2048, 32768 + 1024); WAIT_L(8); G2_SCHED;
#pragma unroll
            for (int i = 0; i < 4; ++i) { qs[i] = __builtin_amdgcn_mfma_f32_16x16x32_bf16(fa[i], vb0, qs[i], 0, 0, 0); qs[i] = __builtin_amdgcn_mfma_f32_16x16x32_bf16(fa[4 + i], vb1, qs[i], 0, 0, 0); }
            G2_SCHED; G2_LD8(fa, 32768 + 8192, 2048, 32768 + 8192 + 1024); WAIT_L(8); G2_SCHED;
#pragma unroll
            for (int dt = 0; dt < 4; ++dt) { S[dt] = S[dt] * cd; S[dt] = __builtin_amdgcn_mfma_f32_16x16x32_bf16(fb[dt], vb0, S[dt], 0, 0, 0); S[dt] = __builtin_amdgcn_mfma_f32_16x16x32_bf16(fb[4 + dt], vb1, S[dt], 0, 0, 0); }
            G2_SCHED; WAIT_L(0); G2_SCHED;
#pragma unroll
            for (int dt = 0; dt < 4; ++dt) { S[4 + dt] = S[4 + dt] * cd; S[4 + dt] = __builtin_amdgcn_mfma_f32_16x16x32_bf16(fa[dt], vb0, S[4 + dt], 0, 0, 0); S[4 + dt] = __builtin_amdgcn_mfma_f32_16x16x32_bf16(fa[4 + dt], vb1, S[4 + dt], 0, 0, 0); }
            G2_SCHED;
#undef G2_LD8
#undef G2_SCHED
            if (mode == 0) { const int rec = sl * 64 + lane;
                u32x4 o0, o1; o0.x = cvt_pk_bf16(qs[0][0], qs[0][1]); o0.y = cvt_pk_bf16(qs[0][2], qs[0][3]); o0.z = cvt_pk_bf16(qs[1][0], qs[1][1]); o0.w = cvt_pk_bf16(qs[1][2], qs[1][3]);
                o1.x = cvt_pk_bf16(qs[2][0], qs[2][1]); o1.y = cvt_pk_bf16(qs[2][2], qs[2][3]); o1.z = cvt_pk_bf16(qs[3][0], qs[3][1]); o1.w = cvt_pk_bf16(qs[3][2], qs[3][3]);
                u32x4* op = (u32x4*)(WSP(bf16_t, WS_PROJ) + ((size_t)b * L + (size_t)c * 64 + (rec >> 3)) * N1 + h * 128 + (rec & 7) * 16); op[0] = o0; op[1] = o1; }
            else { float keep = qs[0][0] + qs[1][1] + qs[2][2] + qs[3][3]; asm volatile("" :: "v"(keep)); }
#pragma unroll
            for (int kx = 0; kx < 4; ++kx) Sb[kx] = pack8(S[2 * kx], S[2 * kx + 1]);
            __builtin_amdgcn_s_barrier();
        }
        __builtin_amdgcn_s_setprio(0);
    }
    }
}
DI void gdn_g3(Frame& F) {
    const bf16_t* P1 = WSP(bf16_t, WS_PROJ); bf16_t* mix = WSP(bf16_t, WS_MIX); const int lane = F.lane, e = 2 * lane; const float nw0 = F.in[18][e], nw1 = F.in[18][e + 1];
    for (long trip = F.gwave; trip < (long)T * 6 / 8; trip += F.gwaves) {
        const int ah = (int)(trip & 1), j = (int)((trip >> 1) & 3); const long ch6 = trip >> 3; const int h = (int)(ch6 % 6); const size_t tokb = (size_t)(ch6 / 6) * 64;
        const int rec0 = (e >> 4) * 64 + (e & 15) + 16 * j; const bf16_t* orow = P1 + (tokb + (rec0 >> 3)) * N1 + h * 128 + (rec0 & 7) * 16 + 8 * ah;
        const u32x4 ra = *(const u32x4*)orow, rb = *(const u32x4*)(orow + 16); unsigned zz[8];
#pragma unroll
        for (int k = 0; k < 8; ++k) { const size_t tok = tokb + 16 * (2 * ah + (k >> 2)) + 4 * j + (k & 3); zz[k] = *(const unsigned*)(P1 + tok * N1 + 2304 + h * 128 + e); }
#pragma unroll
        for (int k = 0; k < 8; ++k) { const size_t tok = tokb + 16 * (2 * ah + (k >> 2)) + 4 * j + (k & 3); const float o0 = u4elem(ra, k), o1 = u4elem(rb, k);
            const float r = __builtin_amdgcn_rsqf(wave_sum(o0 * o0 + o1 * o1) * (1.0f / 128.0f) + EPS);
            *(unsigned*)(mix + tok * 1024 + h * 128 + e) = pk2(o0 * r * nw0 * silu_f(bflo(zz[k])), o1 * r * nw1 * silu_f(bfhi(zz[k]))); }
    }
}

DI void s5_glu_gate(Frame& F) {
    pg8::StaticOrder S; S.init(T, 256, F.G, (int)blockIdx.x); pg8::Unit u; const bf16_t* yg = WSP(bf16_t, WS_YG); bf16_t* mix = WSP(bf16_t, WS_MIX);
    WAIT_V(0); __syncthreads();
    for (int i = 0; S.next(i, u); ++i)
        for (int it = F.tid; it < 256 * 32; it += NTHREADS) { const size_t row = (size_t)u.pm * 256 + (it >> 5); const int c = (it & 31) * 8;
            const u32x4 y = *(const u32x4*)(yg + row * 256 + c); u32x4* zp = (u32x4*)(mix + row * 1024 + 768 + c); const u32x4 z = *zp; u32x4 o;
            o.x = pk2(__uint_as_float(y.x << 16) * sigmoid_f(__uint_as_float(z.x << 16)), __uint_as_float(y.x & 0xffff0000u) * sigmoid_f(__uint_as_float(z.x & 0xffff0000u)));
            o.y = pk2(__uint_as_float(y.y << 16) * sigmoid_f(__uint_as_float(z.y << 16)), __uint_as_float(y.y & 0xffff0000u) * sigmoid_f(__uint_as_float(z.y & 0xffff0000u)));
            o.z = pk2(__uint_as_float(y.z << 16) * sigmoid_f(__uint_as_float(z.z << 16)), __uint_as_float(y.z & 0xffff0000u) * sigmoid_f(__uint_as_float(z.z & 0xffff0000u)));
            o.w = pk2(__uint_as_float(y.w << 16) * sigmoid_f(__uint_as_float(z.w << 16)), __uint_as_float(y.w & 0xffff0000u) * sigmoid_f(__uint_as_float(z.w & 0xffff0000u)));
            *zp = o; }
}

DI void s5_state_scan(Frame& F) {
    constexpr int NC16 = L / 16, NSEG = NC16 >= 32 ? 32 : NC16, SEGLEN = NC16 / NSEG; static_assert(SEGLEN >= 1 && (SEGLEN & (SEGLEN - 1)) == 0, "S5 scan segments");
    const bf16_t* HL = WSP(bf16_t, WS_S5_HL); bf16_t* HP = WSP(bf16_t, WS_S5_HP); LAS f32x2* E = (LAS f32x2*)F.lds;
    const int tr = F.tid & 15, seg = F.tid >> 4;
    for (int blk = blockIdx.x; blk < 128; blk += F.G) {
        const int gt = blk * 16 + tr, n = gt & 63, g = (gt >> 6) & 15, b = gt >> 10; double lre, lim, fre, fim; s5_lam(F.in, g, n, lre, lim, fre, fim);
#pragma unroll
        for (int k = 0; k < 4; ++k) { const double t = lre * lre - lim * lim; lim = 2.0 * lre * lim; lre = t; }
        const float pr = (float)lre, pi = (float)lim;
        for (int k = 1; k < SEGLEN; k <<= 1) { const double t = lre * lre - lim * lim; lim = 2.0 * lre * lim; lre = t; }
        const float sr = (float)lre, si = (float)lim;
        const int sg = seg < NSEG ? seg : 0; const size_t base = ((size_t)g * (T / 16) + (size_t)b * NC16 + (size_t)sg * SEGLEN) * 128 + n;
        float lr[SEGLEN], li[SEGLEN];
#pragma unroll
        for (int k = 0; k < SEGLEN; ++k) { lr[k] = bf2f(HL[base + (size_t)k * 128]); li[k] = bf2f(HL[base + (size_t)k * 128 + 64]); }
        float hre = 0.f, him = 0.f;
#pragma unroll
        for (int k = 0; k < SEGLEN; ++k) { const float t = pr * hre - pi * him + lr[k], u2 = pr * him + pi * hre + li[k]; lr[k] = hre; li[k] = him; hre = t; him = u2; }
        E[tr * 32 + seg] = (f32x2){hre, him};
        __syncthreads();
        float cre = 0.f, cim = 0.f;
        for (int j = 0; j < (seg < NSEG ? seg : 0); ++j) { const f32x2 e = E[tr * 32 + j]; const float t = sr * cre - si * cim + e[0]; cim = sr * cim + si * cre + e[1]; cre = t; }
#pragma unroll
        for (int k = 0; k < SEGLEN; ++k) { if (seg < NSEG) { HP[base + (size_t)k * 128] = f2bf(lr[k] + cre); HP[base + (size_t)k * 128 + 64] = f2bf(li[k] + cim); } const float t = pr * cre - pi * cim; cim = pr * cim + pi * cre; cre = t; }
        __syncthreads();
    }
}
DI void final_norm_load(Frame& F, int batch, u32x4 (&rows)[16][2]) {
    const bf16_t* xr = XRES;
#pragma unroll
    for (int k = 0; k < 16; ++k) { const long m = (long)F.gwave + (long)(batch * 16 + k) * F.gwaves; rows[k][0] = (u32x4){0u, 0u, 0u, 0u}; rows[k][1] = rows[k][0];
        if (m < T) { const u32x4* p = (const u32x4*)(xr + (size_t)m * D) + F.lane; rows[k][0] = p[0]; rows[k][1] = p[64]; } }
}
DI void final_norm_store(Frame& F, int batch, const u32x4 (&rows)[16][2]) {
    const f32x4* wr = (const f32x4*)F.in[33]; f32x4 wv[4];
#pragma unroll
    for (int j = 0; j < 2; ++j) { wv[2 * j] = wr[128 * j + 2 * F.lane]; wv[2 * j + 1] = wr[128 * j + 2 * F.lane + 1]; }
#pragma unroll
    for (int k = 0; k < 16; ++k) { const long m = (long)F.gwave + (long)(batch * 16 + k) * F.gwaves; f32x4 v[4]; float s = 0.f;
#pragma unroll
        for (int j = 0; j < 2; ++j) { const u32x4 b = rows[k][j]; v[2 * j] = (f32x4){bflo(b.x), bfhi(b.x), bflo(b.y), bfhi(b.y)}; v[2 * j + 1] = (f32x4){bflo(b.z), bfhi(b.z), bflo(b.w), bfhi(b.w)}; }
#pragma unroll
        for (int j = 0; j < 4; ++j) s += (v[j][0] * v[j][0] + v[j][1] * v[j][1]) + (v[j][2] * v[j][2] + v[j][3] * v[j][3]);
        const float rs = __builtin_amdgcn_rsqf(wave_sum(s) * (1.0f / D) + EPS);
        if (m < T) { f32x4* orow = (f32x4*)(F.out + (size_t)m * D);
#pragma unroll
            for (int j = 0; j < 2; ++j) { orow[128 * j + 2 * F.lane] = v[2 * j] * rs * wv[2 * j]; orow[128 * j + 2 * F.lane + 1] = v[2 * j + 1] * rs * wv[2 * j + 1]; } } }
}

#ifndef CPU_EMU
#define XB_TMO      128
#define XB_XCNT(j)  (256  + 64 * (j))
#define XB_XSUB(j)  (1280 + 64 * (j))
#define XB_XGEN(j)  (2304 + 64 * (j))
#define XB_TOP      3328
#define XB_TOPGEN   3392
#define XCD_BAR_WORDS 3456
#define XB_SPIN_CAP (1u << 18)
DI unsigned xb_ld(unsigned* p)              { return __hip_atomic_load(p, __ATOMIC_RELAXED, __HIP_MEMORY_SCOPE_AGENT); }
DI unsigned xb_add(unsigned* p, unsigned v) { return __hip_atomic_fetch_add(p, v, __ATOMIC_RELAXED, __HIP_MEMORY_SCOPE_AGENT); }
DI unsigned xb_xcc_id() { return (unsigned)__builtin_amdgcn_s_getreg((3 << 11) | 20) & 0xFu; }
#define XB_SPIN(cond, bar) do { unsigned _sp = 0; while (cond) { __builtin_amdgcn_s_sleep(1); \
    if ((++_sp & 255u) == 0u) { if (xb_ld(&(bar)[XB_TMO])) break; if (_sp > XB_SPIN_CAP) { atomicAdd(&(bar)[XB_TMO], 1u); break; } } } } while (0)
struct XcdBarrier { unsigned* bar; unsigned x; volatile LAS unsigned* st; };
DI XcdBarrier xcd_barrier_post(unsigned* bar, volatile LAS unsigned* st) {
    XcdBarrier b; b.bar = bar; b.x = xb_xcc_id(); b.st = st;
    if (threadIdx.x == 0) (void)xb_add(&bar[XB_XCNT(b.x)], 1u);
    return b;
}
DI void xcd_barrier_complete(unsigned* bar, unsigned x, unsigned& nloc, unsigned& nx) {
    const unsigned G = gridDim.x * gridDim.y * gridDim.z;
    unsigned sum, cnt, mine, sp = 0u;
    for (;;) {
        sum = 0u; cnt = 0u; mine = 0u;
#pragma unroll
        for (unsigned j = 0; j < 16; ++j) { const unsigned c = xb_ld(&bar[XB_XCNT(j)]); sum += c; cnt += (c > 0u) ? 1u : 0u; mine = (j == x) ? c : mine; }
        if (sum == G) break;
        __builtin_amdgcn_s_sleep(1);
        if ((++sp & 255u) == 0u) { if (xb_ld(&bar[XB_TMO])) break; if (sp > XB_SPIN_CAP) { atomicAdd(&bar[XB_TMO], 1u); break; } }
    }
    nloc = mine > 0u ? mine : 1u; nx = cnt > 0u ? cnt : 1u;
}
DI void xcd_barrier(const XcdBarrier& b) {
    asm volatile("s_waitcnt vmcnt(0)" ::: "memory");
    __syncthreads();
    if (threadIdx.x == 0) {
        unsigned* bar = b.bar;
        __builtin_amdgcn_s_waitcnt(0);
        unsigned nloc = b.st[0], nx = b.st[1];
        if (nloc == 0u) { xcd_barrier_complete(bar, b.x, nloc, nx); b.st[0] = nloc; b.st[1] = nx; }
        const unsigned old = xb_add(&bar[XB_XSUB(b.x)], 1u);
        const unsigned gen = old / nloc;
        if (old + 1u == (gen + 1u) * nloc) {
            __builtin_amdgcn_fence(__ATOMIC_RELEASE, "agent");
            asm volatile("s_waitcnt vmcnt(0)" ::: "memory");
            const unsigned og = xb_add(&bar[XB_TOP], 1u);
            const unsigned tgt = (og / nx + 1u) * nx;
            if (og + 1u != tgt) XB_SPIN(xb_ld(&bar[XB_TOP]) < tgt, bar);
            __builtin_amdgcn_fence(__ATOMIC_ACQUIRE, "agent");
            xb_add(&bar[XB_XGEN(b.x)], 1u);
            asm volatile("s_waitcnt vmcnt(0)" ::: "memory");
        } else {
            XB_SPIN(xb_ld(&bar[XB_XGEN(b.x)]) == gen, bar);
            __builtin_amdgcn_fence(__ATOMIC_ACQUIRE, "agent");
            asm volatile("s_waitcnt vmcnt(0)" ::: "memory");
        }
    }
    __syncthreads();
}
#endif

constexpr int NPHASES = 17;
DI void run_phase(Frame& F, int ph) {
    using namespace pg8;
    StaticOrder S;
    switch (ph) {
    case 0: p0_prologue(F); break;
    case 1: { Gemm g{WSP(bf16_t, WS_W_IN0), D, 0}; AStd A{(const char*)WSP(bf16_t, WS_XN), D}; S.init(T, N0, F.G, (int)blockIdx.x); EpiProj E{WSP(bf16_t, WS_PROJ), N0, nullptr, 0, -1, nullptr, nullptr, nullptr, nullptr}; gemm_phase(F.lds, g, A, S, E); } break;
    case 2: l0_phase_a(F); break;
    case 3: l0_phase_b(F); break;
    case 4: l0_phase_c(F); break;
    case 5: { Gemm g{WSP(bf16_t, WS_W_OUT0), D, 0}; AStd A{(const char*)WSP(bf16_t, WS_MIX), D}; S.init(T, D, F.G, (int)blockIdx.x); EpiResid<true> E{F.in[0], XRES, WSP(float, WS_SSQ)}; gemm_phase(F.lds, g, A, S, E); } break;
    case 6: { Gemm g{WSP(bf16_t, WS_W_UP0), D, 0}; AStd A{(const char*)XRES, D}; S.init(T, DFF, F.G, (int)blockIdx.x); LAS float* rsl = (LAS float*)(F.lds + 131072); prep_rs(rsl, S, WSP(float, WS_SSQ)); EpiProj E{WSP(bf16_t, WS_PROJ), DFF, WSP(float, WS_SSQ), 1, -1, nullptr, nullptr, nullptr, rsl}; gemm_phase(F.lds, g, A, S, E); } break;
    case 7: { Gemm g{WSP(bf16_t, WS_W_DN0), DFF, 0}; AStd A{(const char*)WSP(bf16_t, WS_PROJ), DFF}; S.init(T, D, F.G, (int)blockIdx.x); EpiResid<false> E{nullptr, XRES, WSP(float, WS_SSQ)}; gemm_phase(F.lds, g, A, S, E); } break;
    case 8: { Gemm g{WSP(bf16_t, WS_W_IN1), D, 0}; AStd A{(const char*)XRES, D}; S.init(T, N1G, F.G, (int)blockIdx.x); LAS float* rsl = (LAS float*)(F.lds + 131072); prep_rs(rsl, S, WSP(float, WS_SSQ)); EpiProj E{WSP(bf16_t, WS_PROJ), N1, WSP(float, WS_SSQ), 0, 13, WSP(float, WS_BG), F.in[16], F.in[17], rsl}; gemm_phase(F.lds, g, A, S, E); } break;
    case 9: { Gemm g{WSP(bf16_t, WS_S5_H), 256, (size_t)256 * 256 * 2}; AS5 A{(const char*)(WSP(bf16_t, WS_PROJ) + 3072), (const char*)WSP(bf16_t, WS_S5_HP)}; BatchOrder B; B.init(T / 16 / 256, 16, F.G, (int)blockIdx.x);
              EpiS5State E{WSP(bf16_t, WS_S5_HL)}; gemm_phase(F.lds, g, A, B, E); } break;
    case 10: s5_state_scan(F); break;
    case 11: { const bool split = F.G > 96;
              const int bx = (int)blockIdx.x; const bool scan_wg = bx < 32 || (bx < 64 && (bx & 7) < 4);
              const int pidx = bx >= 64 ? bx - 64 + 16 : ((bx - 32) >> 3) * 4 + (bx & 7) - 4;
              if (!split) gdn_g1(F, bx, F.G);
              if (!split || scan_wg) gdn_g2(F);
              if (!split || !scan_wg) { if (split) gdn_g1(F, pidx, F.G - 48); __syncthreads(); Gemm g{WSP(bf16_t, WS_S5_MG), 384, (size_t)256 * 384 * 2}; AS5 A{(const char*)(WSP(bf16_t, WS_PROJ) + 3072), (const char*)WSP(bf16_t, WS_S5_HP)};
                  BatchOrder B; B.init(T / 16 / 256, 16, split ? F.G - 48 : F.G, split ? pidx : bx); EpiS5Y E{WSP(bf16_t, WS_YG)}; gemm_phase(F.lds, g, A, B, E); } } break;
    case 12: { Gemm g{WSP(bf16_t, WS_S5_WG), 256, 0}; AStd A{(const char*)WSP(bf16_t, WS_YG), 256}; S.init(T, 256, F.G, (int)blockIdx.x); EpiS5Glu E{F.in[28], WSP(bf16_t, WS_MIX)}; gemm_phase(F.lds, g, A, S, E); s5_glu_gate(F); gdn_g3(F); } break;
    case 13: { Gemm g{WSP(bf16_t, WS_W_OUT1), D, 0}; AStd A{(const char*)WSP(bf16_t, WS_MIX), D}; S.init(T, D, F.G, (int)blockIdx.x); EpiResid<false> E{nullptr, XRES, WSP(float, WS_SSQ)}; gemm_phase(F.lds, g, A, S, E); } break;
    case 14: { Gemm g{WSP(bf16_t, WS_W_UP1), D, 0}; AStd A{(const char*)XRES, D}; S.init(T, DFF, F.G, (int)blockIdx.x); LAS float* rsl = (LAS float*)(F.lds + 131072); prep_rs(rsl, S, WSP(float, WS_SSQ)); EpiProj E{WSP(bf16_t, WS_PROJ), DFF, WSP(float, WS_SSQ), 1, -1, nullptr, nullptr, nullptr, rsl}; gemm_phase(F.lds, g, A, S, E); } break;
    case 15: { Gemm g{WSP(bf16_t, WS_W_DN1), DFF, 0}; AStd A{(const char*)WSP(bf16_t, WS_PROJ), DFF}; S.init(T, D, F.G, (int)blockIdx.x); EpiResid<false> E{nullptr, XRES, WSP(float, WS_SSQ)}; gemm_phase(F.lds, g, A, S, E); } break;
    case 16: break;
#ifdef CPU_EMU
    case 100: { Gemm g{WSP(bf16_t, WS_S5_H), 256, (size_t)256 * 256 * 2}; AS5 A{(const char*)(WSP(bf16_t, WS_PROJ) + 3072), (const char*)WSP(bf16_t, WS_S5_HP)}; BatchOrder B; B.init(T / 16 / 256, 16, F.G, (int)blockIdx.x); EpiS5State E{WSP(bf16_t, WS_S5_HL)}; gemm_phase(F.lds, g, A, B, E); } break;
    case 101: s5_state_scan(F); break;
    case 102: { Gemm g{WSP(bf16_t, WS_S5_MG), 384, (size_t)256 * 384 * 2}; AS5 A{(const char*)(WSP(bf16_t, WS_PROJ) + 3072), (const char*)WSP(bf16_t, WS_S5_HP)}; BatchOrder B; B.init(T / 16 / 256, 16, F.G, (int)blockIdx.x); EpiS5Y E{WSP(bf16_t, WS_YG)}; gemm_phase(F.lds, g, A, B, E); } break;
    case 103: { Gemm g{WSP(bf16_t, WS_S5_WG), 256, 0}; AStd A{(const char*)WSP(bf16_t, WS_YG), 256}; S.init(T, 256, F.G, (int)blockIdx.x); EpiS5Glu E{F.in[28], WSP(bf16_t, WS_MIX)}; gemm_phase(F.lds, g, A, S, E); s5_glu_gate(F); } break;
#endif
    default: break;
    }
}

template <int PH> __global__ void __launch_bounds__(NTHREADS, 2) phase_kernel(Params p) {
#ifndef CPU_EMU
    extern __shared__ __attribute__((aligned(16))) unsigned char lds_raw[];
    LAS unsigned char* lds = (LAS unsigned char*)lds_raw;
#else
    unsigned char* lds = emu::cur->blk->lds;
#endif
    Frame F;
    F.lds = lds; F.tid = threadIdx.x; F.lane = F.tid & 63; F.wave = __builtin_amdgcn_readfirstlane(F.tid >> 6); F.G = gridDim.x;
    F.gtid = (long)blockIdx.x * NTHREADS + F.tid; F.gthreads = (long)F.G * NTHREADS; F.gwave = (int)blockIdx.x * (NTHREADS / 64) + F.wave; F.gwaves = F.G * (NTHREADS / 64);
#ifndef CPU_EMU
    F.in.q = (const KAS Params*)__builtin_amdgcn_kernarg_segment_ptr();
#else
    F.in.q = &p;
#endif
    F.out = p.out; F.ws = p.ws;
    if (PH == NPHASES - 1) { for (int bt = 0; bt * 16 * F.gwaves < T; ++bt) { u32x4 rows[16][2]; final_norm_load(F, bt, rows); cg::this_grid().sync(); final_norm_store(F, bt, rows); if ((bt + 1) * 16 * F.gwaves < T) cg::this_grid().sync(); } }
    run_phase(F, PH);
}
#if N_LAUNCH_MODE == 1 || defined(CPU_EMU)
#ifndef CPU_EMU
#define GRID_SEAM(ph) do { if ((ph) == 0) cg::this_grid().sync(); else xcd_barrier(xb); } while (0)
template <int PH> DI void run_all(Frame& F, int hi, const XcdBarrier& xb) {
#else
#define GRID_SEAM(ph) cg::this_grid().sync()
template <int PH> DI void run_all(Frame& F, int hi, int xb) {
#endif
    if constexpr (PH < NPHASES) {
        if (PH < hi) {
#ifndef CPU_EMU
            asm volatile("" : "+s"(F.in.q));
#endif
            F.out = F.in.q->out; F.ws = F.in.q->ws;
            if (PH == NPHASES - 1) { for (int bt = 0; bt * 16 * F.gwaves < T; ++bt) { u32x4 rows[16][2]; final_norm_load(F, bt, rows); GRID_SEAM(1); final_norm_store(F, bt, rows); if ((bt + 1) * 16 * F.gwaves < T) GRID_SEAM(1); } }
            run_phase(F, PH); if (PH == PROBE_REPEAT) { GRID_SEAM(1); if (PH == 11) { if (G2_PROBE_MODE == 9) gdn_g1(F, (int)blockIdx.x, F.G); else if ((int)blockIdx.x < 64) gdn_g2(F, G2_PROBE_MODE); } else run_phase(F, PH); }
            if (PH + 1 < hi) GRID_SEAM(PH); }
        run_all<PH + 1>(F, hi, xb);
    }
}
__global__ void __launch_bounds__(NTHREADS, 2) fwd_kernel(Params p) {
#ifndef CPU_EMU
    extern __shared__ __attribute__((aligned(16))) unsigned char lds_raw[];
    LAS unsigned char* lds = (LAS unsigned char*)lds_raw;
#else
    unsigned char* lds = emu::cur->blk->lds;
#endif
    Frame F;
    F.lds = lds; F.tid = threadIdx.x; F.lane = F.tid & 63; F.wave = __builtin_amdgcn_readfirstlane(F.tid >> 6); F.G = gridDim.x;
    F.gtid = (long)blockIdx.x * NTHREADS + F.tid; F.gthreads = (long)F.G * NTHREADS; F.gwave = (int)blockIdx.x * (NTHREADS / 64) + F.wave; F.gwaves = F.G * (NTHREADS / 64);
#ifndef CPU_EMU
    F.in.q = (const KAS Params*)__builtin_amdgcn_kernarg_segment_ptr();
#else
    F.in.q = &p;
#endif
#ifndef CPU_EMU
    volatile LAS unsigned* xst = (volatile LAS unsigned*)(lds + LDS_BYTES - 16);
    if (threadIdx.x == 0) { xst[0] = 0u; xst[1] = 0u; }
    __syncthreads();
    const XcdBarrier xb = xcd_barrier_post((unsigned*)(p.ws + WS_CTL), xst);
    run_all<0>(F, p.ph_hi, xb);
#else
    run_all<0>(F, p.ph_hi, 0);
#endif
}
#endif
template <int PH> static void launch_phases(Params& p, int grid, hipStream_t stream) {
    if constexpr (PH < NPHASES) {
#ifndef CPU_EMU
        static bool attr = false;
        if (!attr) { (void)hipFuncSetAttribute((const void*)phase_kernel<PH>, hipFuncAttributeMaxDynamicSharedMemorySize, LDS_BYTES); attr = true; }
        hipLaunchKernelGGL(phase_kernel<PH>, dim3(grid), dim3(NTHREADS), LDS_BYTES, stream, p);
#endif
        launch_phases<PH + 1>(p, grid, stream);
    }
}

#ifndef CPU_EMU
#if N_LAUNCH_MODE == 1
#define MAIN_KERNEL fwd_kernel
#else
#define MAIN_KERNEL phase_kernel<1>
#endif
extern "C" void kernel_launch(void* const* d_in, const int* in_sizes, int n_in, void* d_out, int out_size, void* d_ws, size_t ws_size, hipStream_t stream) {
    static int grid = 0;
    if (grid == 0) {
        if (n_in != 34 || out_size != T * D || ws_size < WS_END) { fprintf(stderr, "kernel_launch: unexpected shapes (n_in %d out %d ws %zu need %zu)\n", n_in, out_size, ws_size, (size_t)WS_END); grid = -1; return; }
        int dev = 0, cus = 0, per_cu = 0;
        (void)hipGetDevice(&dev); (void)hipDeviceGetAttribute(&cus, hipDeviceAttributeMultiprocessorCount, dev);
        if (hipFuncSetAttribute((const void*)MAIN_KERNEL, hipFuncAttributeMaxDynamicSharedMemorySize, LDS_BYTES) != hipSuccess) { fprintf(stderr, "kernel_launch: hipFuncSetAttribute failed\n"); grid = -1; return; }
        if (hipOccupancyMaxActiveBlocksPerMultiprocessor(&per_cu, (const void*)MAIN_KERNEL, NTHREADS, LDS_BYTES) != hipSuccess || per_cu < 1) { fprintf(stderr, "kernel_launch: occupancy query says %d\n", per_cu); per_cu = 1; }
        (void)hipGetLastError();
        grid = cus;
    }
    if (grid < 0) return;
    Params p{};
    for (int i = 0; i < 34; ++i) p.in[i] = (const float*)d_in[i];
    p.out = (float*)d_out; p.ws = (unsigned char*)d_ws;
#if N_LAUNCH_MODE == 1
    if (hipMemsetAsync((char*)d_ws + WS_CTL, 0, 32768, stream) != hipSuccess) { fprintf(stderr, "kernel_launch: hipMemsetAsync failed\n"); return; }
    p.ph_lo = 0; p.ph_hi = NPHASES;
    void* args[] = {&p};
    hipError_t e = hipLaunchCooperativeKernel((const void*)fwd_kernel, dim3(grid), dim3(NTHREADS), args, LDS_BYTES, stream);
    if (e != hipSuccess) fprintf(stderr, "kernel_launch: cooperative launch failed: %s (grid %d)\n", hipGetErrorString(e), grid);
#else
    launch_phases<0>(p, grid, stream);
#endif
}
#endif
```
